# Optimizing an MI355X kernel written in HIP

```python
import math
import jax, jax.numpy as jnp
from jax import lax
import numpy as np

D_MODEL = 1024
BATCH = 16
SEQ = 2048
DEPTH = 1

D_CONV = D_MODEL // 2
D_ATTN = D_MODEL - D_CONV
HEAD_DIM = 64
N_HEADS = D_ATTN // HEAD_DIM
D_MIX = D_CONV + D_ATTN
D_IN_PROJ = 2 * D_CONV + 3 * D_ATTN
CONV_WIDTH = 31
DILATED_PATTERNS = ((128, 1), (512, 4), (2048, 16))
ATTN_BLOCK = 128
PEER_HEADS = 8
PEER_NKEYS = 128
PEER_QDIM = 256
PEER_TOPK = 16
PEER_CHUNK = 128
N_EXPERTS = PEER_NKEYS * PEER_NKEYS
ALPHA = (2.0 * DEPTH) ** 0.25
BETA = (8.0 * DEPTH) ** -0.25
LN_EPS = 1e-5
NEG_INF = -1e30

kernel_name = "hymba_conformer_dilated_alibi_peer_deepnorm"


def layer_norm(x, g, b):
    xf = x.astype(jnp.float32)
    mu = jnp.mean(xf, axis=-1, keepdims=True)
    var = jnp.mean(jnp.square(xf - mu), axis=-1, keepdims=True)
    return ((xf - mu) * lax.rsqrt(var + LN_EPS)).astype(x.dtype) * g + b


def alibi_slopes():
    return 2.0 ** (-8.0 * jnp.arange(1, N_HEADS + 1, dtype=jnp.float32) / N_HEADS)


def conformer_conv(u, w_dw, b_dw, g, b):
    a, gate = jnp.split(u, 2, axis=-1)
    hdn = a * jax.nn.sigmoid(gate)
    hdn = lax.conv_general_dilated(
        hdn, w_dw[:, None, :], window_strides=(1,),
        padding=((CONV_WIDTH - 1, 0),),
        dimension_numbers=("NWC", "WIO", "NWC"),
        feature_group_count=D_CONV) + b_dw
    hdn = layer_norm(hdn, g, b)
    return jax.nn.silu(hdn)


def dilated_branch(q, k, v, slopes, window, dilation):
    B, S, H, dh = q.shape
    L = S // dilation
    n_back = window // dilation
    nb = -(-L // ATTN_BLOCK)
    pad = nb * ATTN_BLOCK - L
    n_prev = -(-n_back // ATTN_BLOCK)
    kw = (n_prev + 1) * ATTN_BLOCK

    def to_stream(t):
        t = t.reshape(B, L, dilation, H, dh).transpose(0, 2, 3, 1, 4)
        t = jnp.pad(t, ((0, 0), (0, 0), (0, 0), (0, pad), (0, 0)))
        return t.reshape(B, dilation, H, nb, ATTN_BLOCK, dh)

    def band(t):
        tp = jnp.pad(t, ((0, 0), (0, 0), (0, 0), (n_prev, 0), (0, 0), (0, 0)))
        return jnp.concatenate([tp[:, :, :, i:i + nb] for i in range(n_prev + 1)], axis=4)

    qb = to_stream(q * (HEAD_DIM ** -0.5))
    kb = band(to_stream(k))
    vb = band(to_stream(v))

    q_loc = n_prev * ATTN_BLOCK + jnp.arange(ATTN_BLOCK)[:, None]
    k_loc = jnp.arange(kw)[None, :]
    dist = q_loc - k_loc
    j_glob = (jnp.arange(nb)[:, None, None] - n_prev) * ATTN_BLOCK + k_loc[None]
    valid = ((dist >= 0) & (dist <= n_back))[None] & (j_glob >= 0)
    bias = -slopes[:, None, None, None] * (dist * dilation).astype(jnp.float32)[None, None]

    s = jnp.einsum("bdhnqc,bdhnkc->bdhnqk", qb, kb, preferred_element_type=jnp.float32) + bias
    s = jnp.where(valid, s, NEG_INF)
    m = jnp.max(s, axis=-1, keepdims=True)
    p = jnp.exp(s - m)
    l = jnp.sum(p, axis=-1, keepdims=True)
    o = jnp.einsum("bdhnqk,bdhnkc->bdhnqc", p, vb.astype(jnp.float32)) / l
    lse = (m + jnp.log(l))[..., 0]

    o = o.reshape(B, dilation, H, nb * ATTN_BLOCK, dh)[:, :, :, :L]
    o = o.transpose(0, 3, 1, 2, 4).reshape(B, S, H, dh)
    lse = lse.reshape(B, dilation, H, nb * ATTN_BLOCK)[:, :, :, :L]
    lse = lse.transpose(0, 3, 1, 2).reshape(B, S, H)
    return o, lse


def dilated_attention(q, k, v):
    slopes = alibi_slopes()
    outs, lses = [], []
    for window, dilation in DILATED_PATTERNS:
        o, lse = dilated_branch(q, k, v, slopes, window, dilation)
        outs.append(o)
        lses.append(lse)
    w = jax.nn.softmax(jnp.stack(lses, axis=0), axis=0)
    out = jnp.sum(w[..., None] * jnp.stack(outs, axis=0), axis=0)
    return out.astype(q.dtype)


def peer(h, w_q, sub_keys, u_tab, v_tab):
    B, S, D = h.shape
    tokens = h.reshape(-1, PEER_CHUNK, D)

    def chunk_fn(xc):
        q = (xc @ w_q).reshape(PEER_CHUNK, PEER_HEADS, 2, PEER_QDIM // 2)
        s = jnp.einsum("thpc,hpnc->thpn", q, sub_keys, preferred_element_type=jnp.float32)
        top_s, top_i = lax.top_k(s, PEER_TOPK)
        cand_s = top_s[:, :, 0, :, None] + top_s[:, :, 1, None, :]
        cand_i = top_i[:, :, 0, :, None] * PEER_NKEYS + top_i[:, :, 1, None, :]
        cand_s = cand_s.reshape(PEER_CHUNK, PEER_HEADS, PEER_TOPK * PEER_TOPK)
        cand_i = cand_i.reshape(PEER_CHUNK, PEER_HEADS, PEER_TOPK * PEER_TOPK)
        best_s, best_pos = lax.top_k(cand_s, PEER_TOPK)
        idx = jnp.take_along_axis(cand_i, best_pos, axis=-1)
        g = jax.nn.softmax(best_s, axis=-1)
        u = u_tab[idx]
        act = jax.nn.gelu(jnp.einsum("thkd,td->thk", u, xc), approximate=False)
        v = v_tab[idx]
        return jnp.einsum("thk,thkd->td", (g * act).astype(xc.dtype), v)

    return lax.map(chunk_fn, tokens).reshape(B, S, D)


def setup_inputs(seed: int = 0) -> dict:
    key = jax.random.key(seed)
    ks = jax.random.split(key, 20)
    f32 = jnp.float32
    nrm = lambda k, shape: jax.random.normal(k, shape, dtype=f32)
    return {
        "x": nrm(ks[0], (BATCH, SEQ, D_MODEL)),
        "w_in": nrm(ks[1], (DEPTH, D_MODEL, D_IN_PROJ)) * D_MODEL ** -0.5,
        "b_in": nrm(ks[2], (DEPTH, D_IN_PROJ)) * 0.01,
        "conv_w": nrm(ks[3], (DEPTH, CONV_WIDTH, D_CONV)) * CONV_WIDTH ** -0.5,
        "conv_b": nrm(ks[4], (DEPTH, D_CONV)) * 0.01,
        "conv_ln_g": 1.0 + 0.01 * nrm(ks[5], (DEPTH, D_CONV)),
        "conv_ln_b": nrm(ks[6], (DEPTH, D_CONV)) * 0.01,
        "w_out": nrm(ks[7], (DEPTH, D_MIX, D_MODEL)) * (D_MIX ** -0.5) * BETA,
        "b_out": nrm(ks[8], (DEPTH, D_MODEL)) * 0.01,
        "ln1_g": 1.0 + 0.01 * nrm(ks[9], (DEPTH, D_MODEL)),
        "ln1_b": nrm(ks[10], (DEPTH, D_MODEL)) * 0.01,
        "peer_wq": nrm(ks[11], (DEPTH, D_MODEL, PEER_HEADS * PEER_QDIM)) * D_MODEL ** -0.5,
        "peer_keys": nrm(ks[12], (DEPTH, PEER_HEADS, 2, PEER_NKEYS, PEER_QDIM // 2)) * (PEER_QDIM // 2) ** -0.5,
        "peer_u": nrm(ks[13], (DEPTH, N_EXPERTS, D_MODEL)) * D_MODEL ** -0.5,
        "peer_v": nrm(ks[14], (DEPTH, N_EXPERTS, D_MODEL)) * BETA * PEER_HEADS ** -0.5,
        "ln2_g": 1.0 + 0.01 * nrm(ks[15], (DEPTH, D_MODEL)),
        "ln2_b": nrm(ks[16], (DEPTH, D_MODEL)) * 0.01,
    }


def reference(x, w_in, b_in, conv_w, conv_b, conv_ln_g, conv_ln_b, w_out, b_out,
              ln1_g, ln1_b, peer_wq, peer_keys, peer_u, peer_v, ln2_g, ln2_b):
    B, S, _ = x.shape
    h = x
    for l in range(DEPTH):
        proj = h @ w_in[l] + b_in[l]
        u_conv, q, k, v = jnp.split(proj, [2 * D_CONV, 2 * D_CONV + D_ATTN, 2 * D_CONV + 2 * D_ATTN], axis=-1)
        y_conv = conformer_conv(u_conv, conv_w[l], conv_b[l], conv_ln_g[l], conv_ln_b[l])
        q = q.reshape(B, S, N_HEADS, HEAD_DIM)
        k = k.reshape(B, S, N_HEADS, HEAD_DIM)
        v = v.reshape(B, S, N_HEADS, HEAD_DIM)
        y_attn = dilated_attention(q, k, v).reshape(B, S, D_ATTN)
        y = jnp.concatenate([y_conv, y_attn], axis=-1) @ w_out[l] + b_out[l]
        h = layer_norm(ALPHA * h + y, ln1_g[l], ln1_b[l])
        y = peer(h, peer_wq[l], peer_keys[l], peer_u[l], peer_v[l])
        h = layer_norm(ALPHA * h + y, ln2_g[l], ln2_b[l])
    return h
```

```cpp
#include <hip/hip_runtime.h>
#include <cstdio>

typedef __attribute__((ext_vector_type(8))) short bf16x8;
typedef __attribute__((ext_vector_type(4))) float f32x4;
typedef unsigned short u16;
#define DI __device__ __forceinline__
#define MFMA16(a, b, c) __builtin_amdgcn_mfma_f32_16x16x32_bf16((a), (b), (c), 0, 0, 0)


constexpr int NT = 512;
constexpr int T = 32768;
constexpr int SEQ = 2048;
constexpr int DM = 1024;
constexpr int NPROJ = 2560;
constexpr float ALPHA = 1.189207115002721f;
constexpr float LN_EPS = 1e-5f;
constexpr float LOG2E = 1.4426950408889634f;
constexpr float V_SCALE = 8.f;

constexpr size_t MB = 1024 * 1024;
constexpr size_t WS_XB = 0;
constexpr size_t WS_WIN = WS_XB + 64 * MB;
constexpr size_t WS_WOUT = WS_WIN + 5 * MB;
constexpr size_t WS_WQ = WS_WOUT + 2 * MB;
constexpr size_t WS_KEYS = WS_WQ + 4 * MB;
constexpr size_t WS_UB = WS_KEYS + 1 * MB;
constexpr size_t WS_VB = WS_UB + 32 * MB;
constexpr size_t WS_PU = WS_VB + 32 * MB;
constexpr size_t WS_Q = WS_PU + 64 * MB;
constexpr size_t WS_K = WS_Q + 32 * MB;
constexpr size_t WS_VT = WS_K + 32 * MB;
constexpr size_t WS_VT4 = WS_VT + 32 * MB;
constexpr size_t WS_VT16 = WS_VT4 + 32 * MB;
constexpr size_t WS_K4 = WS_VT16 + 32 * MB;
constexpr size_t WS_MIX = WS_K4 + 32 * MB;
constexpr size_t WS_H1F8 = WS_MIX;
constexpr size_t WS_CBUF = WS_MIX + 32 * MB;
constexpr size_t WS_PDOT = WS_PU;
constexpr size_t WS_YBUF = WS_PU;
constexpr size_t WS_SELI = WS_MIX + 64 * MB;
constexpr size_t WS_SELG = WS_SELI + 16 * MB;
constexpr size_t WS_K16 = WS_SELI;
constexpr size_t WS_BAR = WS_SELG + 16 * MB;
constexpr size_t WS_SU = WS_BAR + 4096;
constexpr size_t WS_SX = WS_SU + 65536;
constexpr size_t WS_END = WS_SX + 131072;

constexpr int LDS_BYTES = 128 * 257 * 4 + 128 * 2 * 16 * 4;

struct Params {
  const float* x; const float* w_in; const float* b_in; const float* conv_w; const float* conv_b; const float* cln_g; const float* cln_b;
  const float* w_out; const float* b_out; const float* ln1_g; const float* ln1_b; const float* wq; const float* keys; const float* ut; const float* vt;
  const float* ln2_g; const float* ln2_b;
  float* out; unsigned char* ws;
  int ph_lo, ph_hi;
};

typedef float f32x2 __attribute__((ext_vector_type(2)));
typedef __bf16 bf16x2_t __attribute__((ext_vector_type(2)));
DI unsigned pack2(float a, float b) { const f32x2 v = {a, b}; const bf16x2_t r = __builtin_convertvector(v, bf16x2_t); return __builtin_bit_cast(unsigned, r); }
DI u16 f2bf(float x) { return (u16)(pack2(x, x) & 0xffffu); }
DI float bf2f(u16 h) { return __uint_as_float(((unsigned)h) << 16); }
DI float bflo(unsigned w) { return __uint_as_float(w << 16); }
DI float bfhi(unsigned w) { return __uint_as_float(w & 0xffff0000u); }
DI float wave_sum(float v) {
#pragma unroll
  for (int o = 32; o > 0; o >>= 1) v += __shfl_xor(v, o, 64);
  return v;
}
DI uint4 cvt8(const float4 a, const float4 b) { uint4 r; r.x = pack2(a.x, a.y); r.y = pack2(a.z, a.w); r.z = pack2(b.x, b.y); r.w = pack2(b.z, b.w); return r; }

DI void cvt_linear(const float* __restrict__ src, u16* __restrict__ dst, size_t n8, size_t gtid, size_t gsz) {
  for (size_t i = gtid; i < n8; i += gsz) {
    const float4 a = *(const float4*)(src + i * 8), b = *(const float4*)(src + i * 8 + 4);
    *(uint4*)(dst + i * 8) = cvt8(a, b);
  }
}
DI unsigned pk4_fp8(float a, float b, float c, float d) {
  int r = 0;
  r = __builtin_amdgcn_cvt_pk_fp8_f32(a, b, r, false);
  r = __builtin_amdgcn_cvt_pk_fp8_f32(c, d, r, true);
  return (unsigned)r;
}
DI void cvt_linear_fp8(const float* __restrict__ src, unsigned char* __restrict__ dst, size_t n16, float scale, size_t gtid, size_t gsz) {
  for (size_t i = gtid; i < n16; i += gsz) {
    const float4 a = *(const float4*)(src + i * 16), b = *(const float4*)(src + i * 16 + 4), c = *(const float4*)(src + i * 16 + 8), d = *(const float4*)(src + i * 16 + 12);
    uint4 r;
    r.x = pk4_fp8(a.x * scale, a.y * scale, a.z * scale, a.w * scale); r.y = pk4_fp8(b.x * scale, b.y * scale, b.z * scale, b.w * scale);
    r.z = pk4_fp8(c.x * scale, c.y * scale, c.z * scale, c.w * scale); r.w = pk4_fp8(d.x * scale, d.y * scale, d.z * scale, d.w * scale);
    *(uint4*)(dst + i * 16) = r;
  }
}
DI unsigned pk4_i8(float a, float b, float c, float d) {
  const int ia = (int)rintf(a), ib = (int)rintf(b), ic = (int)rintf(c), id = (int)rintf(d);
  return (unsigned)(ia & 255) | ((unsigned)(ib & 255) << 8) | ((unsigned)(ic & 255) << 16) | ((unsigned)(id & 255) << 24);
}
DI void cvt_rows_i8(const float* __restrict__ src, unsigned char* __restrict__ dst, float* __restrict__ scale_out, size_t n16, size_t gtid, size_t gsz) {
  for (size_t i = gtid; i < n16; i += gsz) {
    const float4 a = *(const float4*)(src + i * 16), b = *(const float4*)(src + i * 16 + 4), c = *(const float4*)(src + i * 16 + 8), d = *(const float4*)(src + i * 16 + 12);
    float m = fmaxf(fmaxf(fmaxf(fabsf(a.x), fabsf(a.y)), fmaxf(fabsf(a.z), fabsf(a.w))), fmaxf(fmaxf(fabsf(b.x), fabsf(b.y)), fmaxf(fabsf(b.z), fabsf(b.w))));
    m = fmaxf(m, fmaxf(fmaxf(fmaxf(fabsf(c.x), fabsf(c.y)), fmaxf(fabsf(c.z), fabsf(c.w))), fmaxf(fmaxf(fabsf(d.x), fabsf(d.y)), fmaxf(fabsf(d.z), fabsf(d.w)))));
#pragma unroll
    for (int o = 32; o > 0; o >>= 1) m = fmaxf(m, __shfl_xor(m, o, 64));
    m = fmaxf(m, 1e-30f);
    const float q = 127.f / m;
    uint4 r;
    r.x = pk4_i8(a.x * q, a.y * q, a.z * q, a.w * q); r.y = pk4_i8(b.x * q, b.y * q, b.z * q, b.w * q);
    r.z = pk4_i8(c.x * q, c.y * q, c.z * q, c.w * q); r.w = pk4_i8(d.x * q, d.y * q, d.z * q, d.w * q);
    *(uint4*)(dst + i * 16) = r;
    if ((i & 63) == 0) scale_out[i >> 6] = m * (1.f / 127.f);
  }
}
DI void cvt_transpose(const float* __restrict__ src, u16* __restrict__ dst, int K, int N, size_t gtid, size_t gsz) {
  const size_t total = (size_t)N * (K / 8);
  for (size_t i = gtid; i < total; i += gsz) {
    const int n = (int)(i % N), k8 = (int)(i / N);
    float v[8];
#pragma unroll
    for (int j = 0; j < 8; ++j) v[j] = src[(size_t)(k8 * 8 + j) * N + n];
    uint4 r; r.x = pack2(v[0], v[1]); r.y = pack2(v[2], v[3]); r.z = pack2(v[4], v[5]); r.w = pack2(v[6], v[7]);
    *(uint4*)(dst + (size_t)n * K + k8 * 8) = r;
  }
}

constexpr int STAGE_BYTES = 384 * 128;

typedef __attribute__((address_space(3))) unsigned lds_u32;
template <int WM>
DI void gemm_tile(const u16* __restrict__ A, const u16* __restrict__ Bt, const int K, const int m0, const int n0, char* smem, f32x4 (&acc)[4][4]) {
  constexpr int BM = 64 * WM;
  const int tid = threadIdx.x, lane = tid & 63, w = __builtin_amdgcn_readfirstlane(tid >> 6);
  const int wm = w % WM, wn = w / WM;
  const int g = lane >> 4, r16 = lane & 15;
#pragma unroll
  for (int i = 0; i < 4; ++i)
#pragma unroll
    for (int j = 0; j < 4; ++j) acc[i][j] = f32x4{0.f, 0.f, 0.f, 0.f};
  const int srow = tid >> 3, sc = tid & 7;
  const u16* gp[6];
#pragma unroll
  for (int i = 0; i < 6; ++i) {
    const int row = srow + 64 * i;
    const int c = sc ^ ((row >> 1) & 7);
    gp[i] = (i < WM) ? (A + (size_t)(m0 + row) * K + c * 8) : (Bt + (size_t)(n0 + row - BM) * K + c * 8);
  }
  lds_u32* lbase = (lds_u32*)(smem + tid * 16);
#define STAGE(KOFF, BUF) do { \
    _Pragma("unroll") for (int i = 0; i < 6; ++i) \
      __builtin_amdgcn_global_load_lds((const unsigned*)(gp[i] + (KOFF)), (lds_u32*)((__attribute__((address_space(3))) char*)lbase + (BUF) * STAGE_BYTES + i * 8192), 16, 0, 0); } while (0)
  const int KT = K / 64;
  STAGE(0, 0);
  STAGE(64, 1);
  for (int kt = 0; kt < KT; ++kt) {
    asm volatile("s_waitcnt vmcnt(6)" ::: "memory");
    __builtin_amdgcn_s_barrier();
    const int kn = (kt + 2 < KT ? kt + 2 : KT - 1) * 64;
    const int bn = (kt + 2) % 3, bc = kt % 3;
    STAGE(kn, bn);
    const char* cur = smem + bc * STAGE_BYTES;
    bf16x8 af[2][4], bfr[2][4];
#pragma unroll
    for (int kk = 0; kk < 2; ++kk) {
      const int c = 4 * kk + g;
#pragma unroll
      for (int mi = 0; mi < 4; ++mi) { const int row = 64 * wm + 16 * mi + r16; af[kk][mi] = *(const bf16x8*)(cur + row * 128 + ((c ^ ((row >> 1) & 7)) << 4)); }
#pragma unroll
      for (int ni = 0; ni < 4; ++ni) { const int row = BM + 64 * wn + 16 * ni + r16; bfr[kk][ni] = *(const bf16x8*)(cur + row * 128 + ((c ^ ((row >> 1) & 7)) << 4)); }
    }
#pragma unroll
    for (int kk = 0; kk < 2; ++kk)
#pragma unroll
      for (int mi = 0; mi < 4; ++mi)
#pragma unroll
        for (int ni = 0; ni < 4; ++ni) acc[mi][ni] = MFMA16(af[kk][mi], bfr[kk][ni], acc[mi][ni]);
  }
#undef STAGE
  asm volatile("s_waitcnt vmcnt(0)" ::: "memory");
  __syncthreads();
}

template <int MMG>
DI void tile_coords(const int lin, const int k, const int MT, const int NTN, int& mt, int& nt) {
  const int G = gridDim.x, total = MT * NTN;
  if ((G & 7) == 0 && total % G == 0 && (MT & 7) == 0 && ((MT >> 3) % MMG) == 0) {
    const int x = blockIdx.x & 7, r = blockIdx.x >> 3, q = r + (G >> 3) * k;
    const int mm = q % MMG, rest = q / MMG;
    nt = rest % NTN;
    mt = x * (MT >> 3) + (rest / NTN) * MMG + mm;
  } else { mt = lin / NTN; nt = lin % NTN; }
}

constexpr int CT_PITCH = 132;
DI void stage_acc(const f32x4 (&acc)[4][4], char* smem, const int wm, const int wn, const int g, const int r16) {
  float* ct = (float*)smem;
#pragma unroll
  for (int mi = 0; mi < 4; ++mi)
#pragma unroll
    for (int ni = 0; ni < 4; ++ni)
#pragma unroll
      for (int j = 0; j < 4; ++j) ct[(64 * wm + 16 * mi + 4 * g + j) * CT_PITCH + 64 * wn + 16 * ni + r16] = acc[mi][ni][j];
}

constexpr int BIG_STAGE = 512 * 128;
DI void gemm_tile_big(const u16* __restrict__ A, const u16* __restrict__ Bt, const int K, const int m0, const int n0, char* smem, f32x4 (&acc)[8][4]) {
  const int tid = threadIdx.x, lane = tid & 63, w = __builtin_amdgcn_readfirstlane(tid >> 6);
  const int wm = w & 1, wn = w >> 1;
  const int g = lane >> 4, r16 = lane & 15;
#pragma unroll
  for (int i = 0; i < 8; ++i)
#pragma unroll
    for (int j = 0; j < 4; ++j) acc[i][j] = f32x4{0.f, 0.f, 0.f, 0.f};
  const int srow = tid >> 3, sc = tid & 7;
  const int c = sc ^ ((srow >> 1) & 7);
  const u16* ga = A + (size_t)(m0 + srow) * K + c * 8;
  const u16* gb = Bt + (size_t)(n0 + srow) * K + c * 8;
  const size_t rs = (size_t)64 * K;
  __attribute__((address_space(3))) char* lbase = (__attribute__((address_space(3))) char*)(smem + tid * 16);
#define STAGEB(KOFF, BUF) do { \
    _Pragma("unroll") for (int i = 0; i < 4; ++i) { \
      __builtin_amdgcn_global_load_lds((const unsigned*)(ga + i * rs + (KOFF)), (lds_u32*)(lbase + (BUF) * BIG_STAGE + i * 8192), 16, 0, 0); \
      __builtin_amdgcn_global_load_lds((const unsigned*)(gb + i * rs + (KOFF)), (lds_u32*)(lbase + (BUF) * BIG_STAGE + 32768 + i * 8192), 16, 0, 0); } } while (0)
  const int KT = K / 64;
  STAGEB(0, 0);
  asm volatile("s_waitcnt vmcnt(0)" ::: "memory");
  __builtin_amdgcn_s_barrier();
#pragma unroll 1
  for (int kt = 0; kt < KT; ++kt) {
    STAGEB((kt + 1 < KT ? kt + 1 : kt) * 64, (kt + 1) & 1);
    const char* cur = smem + (kt & 1) * BIG_STAGE;
#pragma unroll
    for (int kk = 0; kk < 2; ++kk) {
      const int cc = 4 * kk + g;
      bf16x8 bfr[4];
#pragma unroll
      for (int ni = 0; ni < 4; ++ni) { const int row = 256 + 64 * wn + 16 * ni + r16; bfr[ni] = *(const bf16x8*)(cur + row * 128 + ((cc ^ ((row >> 1) & 7)) << 4)); }
#pragma unroll
      for (int mi = 0; mi < 8; ++mi) {
        const int row = 128 * wm + 16 * mi + r16;
        const bf16x8 af = *(const bf16x8*)(cur + row * 128 + ((cc ^ ((row >> 1) & 7)) << 4));
#pragma unroll
        for (int ni = 0; ni < 4; ++ni) acc[mi][ni] = MFMA16(af, bfr[ni], acc[mi][ni]);
      }
    }
    asm volatile("s_waitcnt vmcnt(0)" ::: "memory");
    __builtin_amdgcn_s_barrier();
  }
#undef STAGEB
}
template <int HF>
DI void stage_acc_big(const f32x4 (&acc)[8][4], char* smem, const int g, const int r16) {
  const int w = __builtin_amdgcn_readfirstlane(threadIdx.x >> 6), wm = w & 1, wn = w >> 1;
  if ((wn >> 1) != HF) return;
  float* ct = (float*)smem;
#pragma unroll
  for (int mi = 0; mi < 8; ++mi)
#pragma unroll
    for (int ni = 0; ni < 4; ++ni)
#pragma unroll
      for (int j = 0; j < 4; ++j) ct[(128 * wm + 16 * mi + 4 * g + j) * CT_PITCH + 64 * (wn & 1) + 16 * ni + r16] = acc[mi][ni][j];
}

template <int D> DI size_t attn_kidx(int bh, int s, int d) {
  const int r = s % D, l = s / D;
  return ((size_t)((bh * D + r) * (128 / D) + (l >> 4)) * 8 + (d >> 3)) * 128 + (l & 15) * 8 + (d & 7);
}
template <int D> DI size_t attn_vidx(int bh, int s, int d) {
  const int r = s % D, l = s / D;
  return ((size_t)((bh * D + r) * (128 / D) + (l >> 4)) * 64 + d) * 16 + (l & 15);
}

DI void inproj_epilogue(const Params& p, const char* smem, const int m0, const int n0) {
  u16* pu = (u16*)(p.ws + WS_PU); u16* qb = (u16*)(p.ws + WS_Q); u16* kb = (u16*)(p.ws + WS_K); u16* vT = (u16*)(p.ws + WS_VT);
  u16* vT4 = (u16*)(p.ws + WS_VT4); u16* vT16 = (u16*)(p.ws + WS_VT16); u16* k4 = (u16*)(p.ws + WS_K4); u16* k16 = (u16*)(p.ws + WS_K16);
  const float* ct = (const float*)smem;
  if (n0 < 1536) {
    u16* dst = n0 < 1024 ? (pu + (size_t)m0 * 1024 + n0) : (qb + (size_t)m0 * 512 + (n0 - 1024));
    const int ld = n0 < 1024 ? 1024 : 512;
#pragma unroll 4
    for (int i = 0; i < 16; ++i) {
      const int c = threadIdx.x + NT * i, row = c >> 5, ch = c & 31;
      const float4 y = *(const float4*)(ct + row * CT_PITCH + 4 * ch), bv = *(const float4*)(p.b_in + n0 + 4 * ch);
      uint2 r; r.x = pack2(y.x + bv.x, y.y + bv.y); r.y = pack2(y.z + bv.z, y.w + bv.w);
      *(uint2*)(dst + (size_t)row * ld + 4 * ch) = r;
    }
    return;
  }
  const int bbase = (m0 >> 11) * 8, s0 = m0 & 2047;
  if (n0 < 2048) {
    const int cc0 = n0 - 1536;
#pragma unroll 2
    for (int i = 0; i < 8; ++i) {
      const int q = threadIdx.x + NT * i, row = q >> 4, ch16 = q & 15;
      const float4 y0 = *(const float4*)(ct + row * CT_PITCH + 8 * ch16), y1 = *(const float4*)(ct + row * CT_PITCH + 8 * ch16 + 4);
      const float4 b0 = *(const float4*)(p.b_in + n0 + 8 * ch16), b1 = *(const float4*)(p.b_in + n0 + 8 * ch16 + 4);
      uint4 r; r.x = pack2(y0.x + b0.x, y0.y + b0.y); r.y = pack2(y0.z + b0.z, y0.w + b0.w); r.z = pack2(y1.x + b1.x, y1.y + b1.y); r.w = pack2(y1.z + b1.z, y1.w + b1.w);
      const int cc = cc0 + 8 * ch16, bh = bbase + (cc >> 6), d = cc & 63, s = s0 + row;
      *(uint4*)(kb + attn_kidx<1>(bh, s, d)) = r;
      *(uint4*)(k4 + attn_kidx<4>(bh, s, d)) = r;
      *(uint4*)(k16 + attn_kidx<16>(bh, s, d)) = r;
    }
  } else {
    const int cc0 = n0 - 2048;
#pragma unroll 2
    for (int i = 0; i < 8; ++i) {
      const int q = threadIdx.x + NT * i, col = q & 127, cidx = q >> 7;
      const float bias = p.b_in[n0 + col];
      const int cc = cc0 + col, bh = bbase + (cc >> 6), d = cc & 63;
#define V_CHUNK(D, DST) do { \
        const int r_ = cidx % (D), l8_ = (cidx / (D)) * 8; \
        float e_[8]; \
        _Pragma("unroll") for (int j = 0; j < 8; ++j) e_[j] = ct[((D) * (l8_ + j) + r_) * CT_PITCH + col] + bias; \
        uint4 w_; w_.x = pack2(e_[0], e_[1]); w_.y = pack2(e_[2], e_[3]); w_.z = pack2(e_[4], e_[5]); w_.w = pack2(e_[6], e_[7]); \
        *(uint4*)((DST) + attn_vidx<D>(bh, s0 + (D) * l8_ + r_, d)) = w_; } while (0)
      V_CHUNK(1, vT);
      V_CHUNK(4, vT4);
      V_CHUNK(16, vT16);
#undef V_CHUNK
    }
  }
}

DI void phase_inproj(const Params& p, char* smem) {
  const u16* xb = (const u16*)(p.ws + WS_XB);
  const u16* wt = (const u16*)(p.ws + WS_WIN);
  const int lane = threadIdx.x & 63, g = lane >> 4, r16 = lane & 15;
  const int NTN = NPROJ / 256;
  for (int tile = blockIdx.x, kit = 0; tile < (T / 256) * NTN; tile += gridDim.x, ++kit) {
    int mt_, nt_; tile_coords<4>(tile, kit, T / 256, NTN, mt_, nt_);
    const int m0 = mt_ * 256, n0 = nt_ * 256;
    {
      const size_t vt_ = (size_t)tile * NT + threadIdx.x, vsz_ = (size_t)(T / 256) * NTN * NT;
      cvt_transpose(p.w_out, (u16*)(p.ws + WS_WOUT), DM, DM, vt_, vsz_);
      cvt_transpose(p.wq, (u16*)(p.ws + WS_WQ), DM, 2048, vt_, vsz_);
    }
    f32x4 acc[8][4];
    gemm_tile_big(xb, wt, DM, m0, n0, smem, acc);
    stage_acc_big<0>(acc, smem, g, r16);
    __syncthreads();
    inproj_epilogue(p, smem, m0, n0);
    __syncthreads();
    stage_acc_big<1>(acc, smem, g, r16);
    __syncthreads();
    inproj_epilogue(p, smem, m0, n0 + 128);
    __syncthreads();
  }
}

template <int D>
DI void attn_task2(const u16* __restrict__ qb, const u16* __restrict__ kd, const u16* __restrict__ vTd, const int b, const int h,
                   const int rA, const int l0A, const int rB, const int l0B, const float c2, f32x4 (&O)[2][4], float (&m_out)[2], float (&l_out)[2]) {
  const int lane = threadIdx.x & 63, g = lane >> 4, i16 = lane & 15;
  const float c1 = 0.125f * LOG2E;
  const float c2d = c2 * (float)D;
  int nsteps = (l0A + 16 + 31) >> 5;
  nsteps = nsteps > 5 ? 5 : nsteps;
  int l0[2] = {l0A, l0B}, lq[2], first[2], bhr[2];
  bf16x8 qf[2][2];
  float m[2] = {-1e30f, -1e30f}, l[2] = {0.f, 0.f};
#pragma unroll
  for (int z = 0; z < 2; ++z) {
    const int r = z ? rB : rA;
    lq[z] = l0[z] + i16;
    const int tq = D * lq[z] + r;
#pragma unroll
    for (int kk = 0; kk < 2; ++kk) qf[z][kk] = *(const bf16x8*)(qb + (size_t)(b * SEQ + tq) * 512 + h * 64 + 8 * g + 32 * kk);
#pragma unroll
    for (int c = 0; c < 4; ++c) O[z][c] = f32x4{0.f, 0.f, 0.f, 0.f};
    first[z] = l0[z] + 16 - 32 * nsteps;
    bhr[z] = ((b * 8 + h) * D + r) * (128 / D);
  }
  bf16x8 kf[2][2][2], vf[2][4];
#define ATTN_LOAD(Z, LK0, KF, VF) do { \
    const int g0_ = (LK0) >> 4; \
    _Pragma("unroll") for (int u = 0; u < 2; ++u) { \
      const int sl_ = 8 * (i16 >> 2) + 4 * u + (i16 & 3); \
      int gk_ = g0_ + (sl_ >> 4); gk_ = gk_ < 0 ? 0 : gk_; \
      const u16* kp_ = kd + ((size_t)(bhr[Z] + gk_) * 8 + g) * 128 + (sl_ & 15) * 8; \
      _Pragma("unroll") for (int kk = 0; kk < 2; ++kk) KF[u][kk] = *(const bf16x8*)(kp_ + (size_t)kk * 512); \
    } \
    { int gv_ = g0_ + (g >> 1); gv_ = gv_ < 0 ? 0 : gv_; \
      const u16* vp_ = vTd + ((size_t)(bhr[Z] + gv_) * 64 + i16) * 16 + 8 * (g & 1); \
      _Pragma("unroll") for (int c = 0; c < 4; ++c) VF[c] = *(const bf16x8*)(vp_ + c * 256); } \
  } while (0)
  for (int st = 0; st < nsteps; ++st) {
    ATTN_LOAD(0, first[0] + 32 * st, kf[0], vf[0]);
    ATTN_LOAD(1, first[1] + 32 * st, kf[1], vf[1]);
#pragma unroll
    for (int z = 0; z < 2; ++z) {
      const int lk0 = first[z] + 32 * st;
      f32x4 sa[2];
#pragma unroll
      for (int u = 0; u < 2; ++u) {
        sa[u] = MFMA16(kf[z][u][0], qf[z][0], (f32x4{0.f, 0.f, 0.f, 0.f}));
        sa[u] = MFMA16(kf[z][u][1], qf[z][1], sa[u]);
      }
      float s[8];
      float mx = -1e30f;
      const bool interior = (lk0 >= 0) && (l0[z] - lk0 >= 31) && (l0[z] + 15 - lk0 <= 128);
      const float dl0 = (float)(lq[z] - lk0 - 8 * g);
      if (interior) {
#pragma unroll
        for (int u = 0; u < 2; ++u)
#pragma unroll
          for (int j = 0; j < 4; ++j) {
            const float sv = sa[u][j] * c1 - c2d * (dl0 - (float)(4 * u + j));
            s[4 * u + j] = sv;
            mx = fmaxf(mx, sv);
          }
      } else {
#pragma unroll
        for (int u = 0; u < 2; ++u)
#pragma unroll
          for (int j = 0; j < 4; ++j) {
            const int lk = lk0 + 8 * g + 4 * u + j;
            const int dl = lq[z] - lk;
            const bool valid = (dl >= 0) && (dl <= 128) && (lk >= 0);
            const float sv = valid ? (sa[u][j] * c1 - c2d * (float)dl) : -1e30f;
            s[4 * u + j] = sv;
            mx = fmaxf(mx, sv);
          }
      }
      mx = fmaxf(mx, __shfl_xor(mx, 16, 64));
      mx = fmaxf(mx, __shfl_xor(mx, 32, 64));
      const float mn = fmaxf(m[z], mx);
      const float al = __builtin_amdgcn_exp2f(m[z] - mn);
      m[z] = mn;
      float ps = 0.f;
      float pv[8];
      if (interior) {
#pragma unroll
        for (int e = 0; e < 8; ++e) { pv[e] = __builtin_amdgcn_exp2f(s[e] - mn); ps += pv[e]; }
      } else {
#pragma unroll
        for (int e = 0; e < 8; ++e) { pv[e] = (s[e] > -1e29f) ? __builtin_amdgcn_exp2f(s[e] - mn) : 0.f; ps += pv[e]; }
      }
      l[z] = l[z] * al + ps;
#pragma unroll
      for (int c = 0; c < 4; ++c) O[z][c] = O[z][c] * al;
      union { bf16x8 v; unsigned u[4]; } pf;
      pf.u[0] = pack2(pv[0], pv[1]); pf.u[1] = pack2(pv[2], pv[3]); pf.u[2] = pack2(pv[4], pv[5]); pf.u[3] = pack2(pv[6], pv[7]);
#pragma unroll
      for (int c = 0; c < 4; ++c) O[z][c] = MFMA16(vf[z][c], pf.v, O[z][c]);
    }
  }
#undef ATTN_LOAD
#pragma unroll
  for (int z = 0; z < 2; ++z) {
    float lz = l[z];
    lz += __shfl_xor(lz, 16, 64);
    lz += __shfl_xor(lz, 32, 64);
    m_out[z] = m[z]; l_out[z] = lz;
  }
}

constexpr int AST_PITCH = 68;
DI float* ast_ptr(float* Ost, int pos, int c, int g) { return Ost + pos * AST_PITCH + 4 * ((4 * c + g) ^ ((pos >> 4) & 15)); }

DI void phase_attn(const Params& p, char* smem) {
  const u16* qb = (const u16*)(p.ws + WS_Q); const u16* kb = (const u16*)(p.ws + WS_K);
  const u16* vT1 = (const u16*)(p.ws + WS_VT); const u16* vT4 = (const u16*)(p.ws + WS_VT4); const u16* vT16 = (const u16*)(p.ws + WS_VT16);
  const u16* k4 = (const u16*)(p.ws + WS_K4); const u16* k16 = (const u16*)(p.ws + WS_K16);
  u16* mix = (u16*)(p.ws + WS_MIX);
  float* Ost = (float*)smem; float* mst = Ost + 256 * AST_PITCH; float* lst = mst + 256;
  const int lane = threadIdx.x & 63, w = __builtin_amdgcn_readfirstlane(threadIdx.x >> 6), g = lane >> 4, i16 = lane & 15;
  for (int item = blockIdx.x; item < 1024; item += gridDim.x) {
    {
      const size_t vt_ = (size_t)item * NT + threadIdx.x, vsz_ = (size_t)1024 * NT;
      cvt_rows_i8(p.ut, p.ws + WS_UB, (float*)(p.ws + WS_SU), (size_t)16384 * DM / 16, vt_, vsz_);
      cvt_linear_fp8(p.vt, p.ws + WS_VB, (size_t)16384 * DM / 16, V_SCALE, vt_, vsz_);
    }
    const int qblk = 7 - (item >> 7), bh = item & 127, b = bh >> 3, h = bh & 7;
    const int t0 = qblk * 256;
    const float c2 = exp2f(-(float)(h + 1)) * LOG2E;
    {
      f32x4 O[2][4]; float m[2], l[2];
      attn_task2<1>(qb, kb, vT1, b, h, 0, t0 + 32 * w, 0, t0 + 32 * w + 16, c2, O, m, l);
#pragma unroll
      for (int z = 0; z < 2; ++z) {
        const int pos = 16 * (2 * w + z) + i16;
#pragma unroll
        for (int c = 0; c < 4; ++c) *(f32x4*)ast_ptr(Ost, pos, c, g) = O[z][c];
        if (g == 0) { mst[pos] = m[z]; lst[pos] = l[z]; }
      }
    }
    __syncthreads();
    {
      const int i = (2 * w) >> 2, r0 = (2 * w) & 3;
      f32x4 O[2][4]; float m[2], l[2];
      attn_task2<4>(qb, k4, vT4, b, h, r0, (t0 >> 2) + 16 * i, r0 + 1, (t0 >> 2) + 16 * i, c2, O, m, l);
#pragma unroll
      for (int z = 0; z < 2; ++z) {
        const int pos = 64 * i + 4 * i16 + r0 + z;
        const float mo = mst[pos], lo = lst[pos];
        const float mn = fmaxf(mo, m[z]), ao = __builtin_amdgcn_exp2f(mo - mn), an = __builtin_amdgcn_exp2f(m[z] - mn);
#pragma unroll
        for (int c = 0; c < 4; ++c) { float* q = ast_ptr(Ost, pos, c, g); const f32x4 old = *(const f32x4*)q; *(f32x4*)q = old * ao + O[z][c] * an; }
        if (g == 0) { mst[pos] = mn; lst[pos] = lo * ao + l[z] * an; }
      }
    }
    __syncthreads();
    {
      f32x4 O[2][4]; float m[2], l[2];
      attn_task2<16>(qb, k16, vT16, b, h, 2 * w, t0 >> 4, 2 * w + 1, t0 >> 4, c2, O, m, l);
#pragma unroll
      for (int z = 0; z < 2; ++z) {
        const int pos = 16 * i16 + 2 * w + z;
        const float mo = mst[pos], lo = lst[pos];
        const float mn = fmaxf(mo, m[z]), ao = __builtin_amdgcn_exp2f(mo - mn), an = __builtin_amdgcn_exp2f(m[z] - mn);
        const float inv = 1.f / (lo * ao + l[z] * an);
        u16* orow = mix + (size_t)(b * SEQ + t0 + pos) * 1024 + 512 + h * 64 + 4 * g;
#pragma unroll
        for (int c = 0; c < 4; ++c) {
          const f32x4 old = *(const f32x4*)ast_ptr(Ost, pos, c, g);
          const f32x4 o = (old * ao + O[z][c] * an) * inv;
          uint2 v; v.x = pack2(o[0], o[1]); v.y = pack2(o[2], o[3]);
          *(uint2*)(orow + 16 * c) = v;
        }
      }
    }
    __syncthreads();
  }
}

DI void phase_conv(const Params& p, char* smem) {
  const u16* pu = (const u16*)(p.ws + WS_PU);
  u16* mix = (u16*)(p.ws + WS_MIX);
  u16* glu = (u16*)smem;
  const int tid = threadIdx.x, lane = tid & 63, w = __builtin_amdgcn_readfirstlane(tid >> 6);
  for (int item = blockIdx.x; item < 512; item += gridDim.x) {
    const int b = item >> 5, s0 = (item & 31) * 64;
    __syncthreads();
    for (int q = tid; q < 94 * 64; q += NT) {
      const int row = q >> 6, c8 = q & 63;
      const int s = s0 - 30 + row;
      uint4 r = uint4{0u, 0u, 0u, 0u};
      if (s >= 0) {
        const u16* src = pu + (size_t)(b * SEQ + s) * 1024 + c8 * 8;
        const uint4 a = *(const uint4*)src, gt = *(const uint4*)(src + 512);
        const unsigned aw[4] = {a.x, a.y, a.z, a.w}, gw[4] = {gt.x, gt.y, gt.z, gt.w};
        unsigned ow[4];
#pragma unroll
        for (int k = 0; k < 4; ++k) {
          const float a0 = bflo(aw[k]), a1 = bfhi(aw[k]), g0 = bflo(gw[k]), g1 = bfhi(gw[k]);
          ow[k] = pack2(a0 / (1.f + __expf(-g0)), a1 / (1.f + __expf(-g1)));
        }
        r = uint4{ow[0], ow[1], ow[2], ow[3]};
      }
      *(uint4*)(glu + row * 512 + c8 * 8) = r;
    }
    __syncthreads();
    float acc[8][8];
    {
      const float4 b0 = *(const float4*)(p.conv_b + lane * 8), b1 = *(const float4*)(p.conv_b + lane * 8 + 4);
#pragma unroll
      for (int i = 0; i < 8; ++i) { acc[i][0] = b0.x; acc[i][1] = b0.y; acc[i][2] = b0.z; acc[i][3] = b0.w; acc[i][4] = b1.x; acc[i][5] = b1.y; acc[i][6] = b1.z; acc[i][7] = b1.w; }
    }
#pragma unroll 4
    for (int j = 0; j < 31; ++j) {
      const float4 w0 = *(const float4*)(p.conv_w + j * 512 + lane * 8), w1 = *(const float4*)(p.conv_w + j * 512 + lane * 8 + 4);
      const float wj[8] = {w0.x, w0.y, w0.z, w0.w, w1.x, w1.y, w1.z, w1.w};
#pragma unroll
      for (int i = 0; i < 8; ++i) {
        const uint4 v = *(const uint4*)(glu + (8 * w + i + j) * 512 + lane * 8);
        acc[i][0] += wj[0] * bflo(v.x); acc[i][1] += wj[1] * bfhi(v.x);
        acc[i][2] += wj[2] * bflo(v.y); acc[i][3] += wj[3] * bfhi(v.y);
        acc[i][4] += wj[4] * bflo(v.z); acc[i][5] += wj[5] * bfhi(v.z);
        acc[i][6] += wj[6] * bflo(v.w); acc[i][7] += wj[7] * bfhi(v.w);
      }
    }
    const float4 g0 = *(const float4*)(p.cln_g + lane * 8), g1 = *(const float4*)(p.cln_g + lane * 8 + 4);
    const float4 c0 = *(const float4*)(p.cln_b + lane * 8), c1 = *(const float4*)(p.cln_b + lane * 8 + 4);
    const float gg[8] = {g0.x, g0.y, g0.z, g0.w, g1.x, g1.y, g1.z, g1.w};
    const float cb[8] = {c0.x, c0.y, c0.z, c0.w, c1.x, c1.y, c1.z, c1.w};
#pragma unroll
    for (int i = 0; i < 8; ++i) {
      float sm = 0.f;
#pragma unroll
      for (int k = 0; k < 8; ++k) sm += acc[i][k];
      const float mean = wave_sum(sm) * (1.f / 512.f);
      float sq = 0.f;
#pragma unroll
      for (int k = 0; k < 8; ++k) { const float d = acc[i][k] - mean; sq += d * d; }
      const float rstd = rsqrtf(wave_sum(sq) * (1.f / 512.f) + LN_EPS);
      float o[8];
#pragma unroll
      for (int k = 0; k < 8; ++k) { const float y = (acc[i][k] - mean) * rstd * gg[k] + cb[k]; o[k] = y / (1.f + __expf(-y)); }
      uint4 r; r.x = pack2(o[0], o[1]); r.y = pack2(o[2], o[3]); r.z = pack2(o[4], o[5]); r.w = pack2(o[6], o[7]);
      *(uint4*)(mix + (size_t)(b * SEQ + s0 + 8 * w + i) * 1024 + lane * 8) = r;
    }
  }
}

DI void outproj_epilogue(const Params& p, const char* smem, const int m0, const int n0) {
  u16* rbuf = (u16*)(p.ws + WS_PU);
  const float* ct = (const float*)smem;
#pragma unroll 4
  for (int i = 0; i < 16; ++i) {
    const int c = threadIdx.x + NT * i, row = c >> 5, ch = c & 31;
    const float4 y = *(const float4*)(ct + row * CT_PITCH + 4 * ch);
    const size_t o = (size_t)(m0 + row) * 1024 + n0 + 4 * ch;
    const float4 xv = *(const float4*)(p.x + o), bv = *(const float4*)(p.b_out + n0 + 4 * ch);
    uint2 r; r.x = pack2(ALPHA * xv.x + y.x + bv.x, ALPHA * xv.y + y.y + bv.y); r.y = pack2(ALPHA * xv.z + y.z + bv.z, ALPHA * xv.w + y.w + bv.w);
    *(uint2*)(rbuf + o) = r;
  }
}
DI void phase_outproj(const Params& p, char* smem) {
  const u16* mix = (const u16*)(p.ws + WS_MIX);
  const u16* wt = (const u16*)(p.ws + WS_WOUT);
  const int lane = threadIdx.x & 63, g = lane >> 4, r16 = lane & 15;
  const int NTN = DM / 256;
  for (int tile = blockIdx.x, kit = 0; tile < (T / 256) * NTN; tile += gridDim.x, ++kit) {
    int mt_, nt_; tile_coords<4>(tile, kit, T / 256, NTN, mt_, nt_);
    const int m0 = mt_ * 256, n0b = nt_ * 256;
    f32x4 acc[8][4];
    gemm_tile_big(mix, wt, DM, m0, n0b, smem, acc);
    stage_acc_big<0>(acc, smem, g, r16);
    __syncthreads();
    outproj_epilogue(p, smem, m0, n0b);
    __syncthreads();
    stage_acc_big<1>(acc, smem, g, r16);
    __syncthreads();
    outproj_epilogue(p, smem, m0, n0b + 128);
    __syncthreads();
  }
}

DI void phase_ln1(const Params& p) {
  const u16* rbuf = (const u16*)(p.ws + WS_PU);
  u16* h1b = (u16*)(p.ws + WS_XB);
  unsigned char* h1f8 = p.ws + WS_H1F8;
  const int lane = threadIdx.x & 63, w = __builtin_amdgcn_readfirstlane(threadIdx.x >> 6);
  float4 gg[4], bb[4];
#pragma unroll
  for (int k = 0; k < 4; ++k) { gg[k] = *(const float4*)(p.ln1_g + 256 * k + 4 * lane); bb[k] = *(const float4*)(p.ln1_b + 256 * k + 4 * lane); }
  for (int tb = blockIdx.x; tb < T / 8; tb += 2 * gridDim.x) {
    const int tb1 = tb + (int)gridDim.x < T / 8 ? tb + (int)gridDim.x : tb;
    const int tt[2] = {tb * 8 + w, tb1 * 8 + w};
    float4 v[2][4];
#pragma unroll
    for (int z = 0; z < 2; ++z)
#pragma unroll
      for (int k = 0; k < 4; ++k) {
        const uint2 q = *(const uint2*)(rbuf + (size_t)tt[z] * 1024 + 256 * k + 4 * lane);
        v[z][k] = float4{bflo(q.x), bfhi(q.x), bflo(q.y), bfhi(q.y)};
      }
#pragma unroll
    for (int z = 0; z < 2; ++z) {
      const int t = tt[z];
      float sm = 0.f;
#pragma unroll
      for (int k = 0; k < 4; ++k) sm += v[z][k].x + v[z][k].y + v[z][k].z + v[z][k].w;
      const float mean = wave_sum(sm) * (1.f / 1024.f);
      float sq = 0.f;
#pragma unroll
      for (int k = 0; k < 4; ++k) { float d; d = v[z][k].x - mean; sq += d * d; d = v[z][k].y - mean; sq += d * d; d = v[z][k].z - mean; sq += d * d; d = v[z][k].w - mean; sq += d * d; }
      const float rstd = rsqrtf(wave_sum(sq) * (1.f / 1024.f) + LN_EPS);
      float4 o[4];
      float am = 0.f;
#pragma unroll
      for (int k = 0; k < 4; ++k) {
        const int d0 = 256 * k + 4 * lane;
        o[k].x = (v[z][k].x - mean) * rstd * gg[k].x + bb[k].x; o[k].y = (v[z][k].y - mean) * rstd * gg[k].y + bb[k].y;
        o[k].z = (v[z][k].z - mean) * rstd * gg[k].z + bb[k].z; o[k].w = (v[z][k].w - mean) * rstd * gg[k].w + bb[k].w;
        am = fmaxf(am, fmaxf(fmaxf(fabsf(o[k].x), fabsf(o[k].y)), fmaxf(fabsf(o[k].z), fabsf(o[k].w))));
        uint2 hb; hb.x = pack2(o[k].x, o[k].y); hb.y = pack2(o[k].z, o[k].w);
        *(uint2*)(h1b + (size_t)t * 1024 + d0) = hb;
      }
#pragma unroll
      for (int of = 32; of > 0; of >>= 1) am = fmaxf(am, __shfl_xor(am, of, 64));
      am = fmaxf(am, 1e-30f);
      const float q = 127.f / am;
#pragma unroll
      for (int k = 0; k < 4; ++k) *(unsigned*)(h1f8 + (size_t)t * 1024 + 256 * k + 4 * lane) = pk4_i8(o[k].x * q, o[k].y * q, o[k].z * q, o[k].w * q);
      if (lane == 0) ((float*)(p.ws + WS_SX))[t] = am * (1.f / 127.f);
    }
  }
}

DI unsigned enc_key(float s) { const unsigned u = __float_as_uint(s); return (u & 0x80000000u) ? ~u : (u | 0x80000000u); }
DI float dec_key(unsigned k) { const unsigned u = (k & 0x80000000u) ? (k & 0x7fffffffu) : ~k; return __uint_as_float(u); }
DI void cswap(unsigned& a, unsigned& b) { const unsigned hi = a > b ? a : b, lo = a > b ? b : a; a = hi; b = lo; }

DI void sort16_desc(unsigned (&v)[16]) {
  constexpr int KS[10] = {2, 4, 4, 8, 8, 8, 16, 16, 16, 16};
  constexpr int JS[10] = {1, 2, 1, 4, 2, 1, 8, 4, 2, 1};
#pragma unroll
  for (int s = 0; s < 10; ++s) {
#pragma unroll
    for (int i = 0; i < 16; ++i) {
      const int l = i ^ JS[s];
      if (l > i) {
        if ((i & KS[s]) == 0) cswap(v[i], v[l]); else cswap(v[l], v[i]);
      }
    }
  }
}
DI void merge16_desc(unsigned (&R)[16], const unsigned (&X)[16]) {
#pragma unroll
  for (int i = 0; i < 16; ++i) R[i] = R[i] > X[15 - i] ? R[i] : X[15 - i];
  constexpr int JS[4] = {8, 4, 2, 1};
#pragma unroll
  for (int s = 0; s < 4; ++s) {
#pragma unroll
    for (int i = 0; i < 16; ++i) {
      const int l = i ^ JS[s];
      if (l > i) cswap(R[i], R[l]);
    }
  }
}

struct CandTab { int i[64]; int j[64]; int n; };
constexpr CandTab make_cands() {
  CandTab t{};
  int n = 0;
  for (int i = 0; i < 16; ++i)
    for (int j = 0; j < 16; ++j)
      if ((i + 1) * (j + 1) <= 16) { t.i[n] = i; t.j[n] = j; ++n; }
  t.n = n;
  for (int k = n; k < 64; ++k) { t.i[k] = 0; t.j[k] = 0; }
  return t;
}

DI void phase_peer_q(const Params& p, char* smem) {
  const u16* h1b = (const u16*)(p.ws + WS_XB);
  const u16* wt = (const u16*)(p.ws + WS_WQ);
  const u16* keysb = (const u16*)(p.ws + WS_KEYS);
  int* sel_i = (int*)(p.ws + WS_SELI);
  float* sel_g = (float*)(p.ws + WS_SELG);
  float* Sbuf = (float*)smem;
  unsigned* xch = (unsigned*)(smem + 128 * 257 * 4);
  const int tid = threadIdx.x, lane = tid & 63, w = __builtin_amdgcn_readfirstlane(tid >> 6), g = lane >> 4, r16 = lane & 15;
  constexpr int WM = 2;
  const int wm = w % WM, wn = w / WM;
  for (int tile = blockIdx.x, kit = 0; tile < (T / 128) * 8; tile += gridDim.x, ++kit) {
    int mt_, nt_; tile_coords<8>(tile, kit, T / 128, 8, mt_, nt_);
    const int m0 = mt_ * 128, hd = nt_, n0 = hd * 256;
    {
      f32x4 acc[4][4];
      gemm_tile<WM>(h1b, wt, DM, m0, n0, smem, acc);
#pragma unroll
      for (int mi = 0; mi < 4; ++mi)
#pragma unroll
        for (int ni = 0; ni < 4; ++ni)
#pragma unroll
          for (int j = 0; j < 4; ++j) {
            const int row = 64 * wm + 16 * mi + 4 * g + j, col = 64 * wn + 16 * ni + r16;
            *(u16*)(smem + row * 512 + (((col >> 3) ^ (row & 15)) << 4) + (col & 7) * 2) = f2bf(acc[mi][ni][j]);
          }
    }
    __syncthreads();
    f32x4 sc[2][2][4];
    {
      const int swm = w & 3, swn = w >> 2;
#pragma unroll
      for (int pp = 0; pp < 2; ++pp) {
#pragma unroll
        for (int mi = 0; mi < 2; ++mi)
#pragma unroll
          for (int ni = 0; ni < 4; ++ni) sc[pp][mi][ni] = f32x4{0.f, 0.f, 0.f, 0.f};
        bf16x8 bfr[4][4];
#pragma unroll
        for (int kk = 0; kk < 4; ++kk)
#pragma unroll
          for (int ni = 0; ni < 4; ++ni) {
            const int n = 64 * swn + 16 * ni + r16;
            bfr[kk][ni] = *(const bf16x8*)(keysb + ((size_t)(((hd * 2 + pp) * 4 + kk) * 4 + g) * 128 + n) * 8);
          }
#pragma unroll
        for (int kk = 0; kk < 4; ++kk) {
          bf16x8 af[2];
#pragma unroll
          for (int mi = 0; mi < 2; ++mi) {
            const int row = 32 * swm + 16 * mi + r16, c = 16 * pp + 4 * kk + g;
            af[mi] = *(const bf16x8*)(smem + row * 512 + ((c ^ (row & 15)) << 4));
          }
#pragma unroll
          for (int mi = 0; mi < 2; ++mi)
#pragma unroll
            for (int ni = 0; ni < 4; ++ni) sc[pp][mi][ni] = MFMA16(af[mi], bfr[kk][ni], sc[pp][mi][ni]);
        }
      }
      __syncthreads();
#pragma unroll
      for (int pp = 0; pp < 2; ++pp)
#pragma unroll
        for (int mi = 0; mi < 2; ++mi)
#pragma unroll
          for (int ni = 0; ni < 4; ++ni)
#pragma unroll
            for (int j = 0; j < 4; ++j) {
              const int row = 32 * swm + 16 * mi + 4 * g + j, n = 64 * swn + 16 * ni + r16;
              Sbuf[row * 257 + pp * 128 + n] = sc[pp][mi][ni][j];
            }
    }
    __syncthreads();
    unsigned R[16];
    const int tok = tid & 127, half = (tid >> 7) & 1;
    if (tid < 256) {
      const float* srow = Sbuf + tok * 257 + half * 128;
#pragma unroll
      for (int i = 0; i < 16; ++i) R[i] = (enc_key(srow[i]) & ~127u) | (unsigned)(127 - i);
      sort16_desc(R);
#pragma unroll 1
      for (int gi = 1; gi < 8; ++gi) {
        unsigned X[16];
#pragma unroll
        for (int i = 0; i < 16; ++i) X[i] = (enc_key(srow[gi * 16 + i]) & ~127u) | (unsigned)(127 - (gi * 16 + i));
        sort16_desc(X);
        merge16_desc(R, X);
      }
#pragma unroll
      for (int i = 0; i < 16; ++i) xch[(tok * 2 + half) * 16 + i] = R[i];
    }
    __syncthreads();
    if (tid < 128) {
      constexpr CandTab CT = make_cands();
      float s1[16], s2[16];
#pragma unroll
      for (int i = 0; i < 16; ++i) { s1[i] = dec_key(R[i] & ~127u); s2[i] = dec_key(xch[(tok * 2 + 1) * 16 + i] & ~127u); }
      unsigned B[16];
#pragma unroll
      for (int gi = 0; gi < 4; ++gi) {
        unsigned X[16];
#pragma unroll
        for (int i = 0; i < 16; ++i) {
          const int c = gi * 16 + i;
          X[i] = (c < CT.n) ? ((enc_key(s1[CT.i[c]] + s2[CT.j[c]]) & ~255u) | (unsigned)(255 - (CT.i[c] * 16 + CT.j[c]))) : 0u;
        }
        sort16_desc(X);
        if (gi == 0) {
#pragma unroll
          for (int i = 0; i < 16; ++i) B[i] = X[i];
        } else merge16_desc(B, X);
      }
      float e[16], sum = 0.f;
      const float s0 = dec_key(B[0] & ~255u);
#pragma unroll
      for (int i = 0; i < 16; ++i) { e[i] = __expf(dec_key(B[i] & ~255u) - s0); sum += e[i]; }
      const float inv = 1.f / sum;
      int ids[16];
#pragma unroll
      for (int i = 0; i < 16; ++i) {
        const int flat = 255 - (int)(B[i] & 255u);
        const int i1 = 127 - (int)(xch[(tok * 2 + 0) * 16 + (flat >> 4)] & 127u);
        const int i2 = 127 - (int)(xch[(tok * 2 + 1) * 16 + (flat & 15)] & 127u);
        ids[i] = i1 * 128 + i2;
        e[i] *= inv;
      }
      int* di = sel_i + (size_t)(m0 + tok) * 128 + hd * 16;
      float* dg = sel_g + (size_t)(m0 + tok) * 128 + hd * 16;
#pragma unroll
      for (int k = 0; k < 4; ++k) {
        *(int4*)(di + 4 * k) = int4{ids[4 * k], ids[4 * k + 1], ids[4 * k + 2], ids[4 * k + 3]};
        *(float4*)(dg + 4 * k) = float4{e[4 * k], e[4 * k + 1], e[4 * k + 2], e[4 * k + 3]};
      }
    }
    __syncthreads();
  }
}

DI unsigned xcc_id() { return (unsigned)__builtin_amdgcn_s_getreg((3 << 11) | 20) & 0xFu; }
DI unsigned ld_agent(const unsigned* q) { return __hip_atomic_load(q, __ATOMIC_RELAXED, __HIP_MEMORY_SCOPE_AGENT); }

DI void fp8x16_to_f32(const uint4& q, f32x2 (&x)[8]) {
  const unsigned w[4] = {q.x, q.y, q.z, q.w};
#pragma unroll
  for (int k = 0; k < 4; ++k) { x[2 * k] = __builtin_amdgcn_cvt_pk_f32_fp8((int)w[k], false); x[2 * k + 1] = __builtin_amdgcn_cvt_pk_f32_fp8((int)w[k], true); }
}
struct SliceOwner { unsigned mine; int nblk; };
DI SliceOwner read_census(const Params& p, const unsigned my_xcc) {
  const unsigned* census = (const unsigned*)(p.ws + WS_BAR) + 64;
  unsigned cnt[8]; unsigned fallback = 8;
#pragma unroll
  for (int x = 7; x >= 0; --x) { cnt[x] = ld_agent(census + 64 * x); if (cnt[x] > 0) fallback = x; }
  SliceOwner o; o.mine = 0u; o.nblk = 1;
#pragma unroll
  for (int x = 0; x < 8; ++x) {
    const unsigned owner = cnt[x] > 0 ? (unsigned)x : fallback;
    if (owner == my_xcc) o.mine |= 1u << x;
    if ((unsigned)x == my_xcc) o.nblk = (int)cnt[x];
  }
  return o;
}

DI void eu_load(const unsigned char* __restrict__ ub8, const int id0, const int id1, const int cs, const int lane, uint4 (&u)[16]) {
#pragma unroll
  for (int i = 0; i < 16; ++i) {
    const int id = __shfl(i < 8 ? id0 : id1, (8 * i + (lane >> 3)) & 63, 64);
    u[i] = *(const uint4*)(ub8 + (size_t)id * 1024 + 128 * cs + 16 * (lane & 7));
  }
}
DI void eu_compute(const uint4 (&u)[16], const uint4& xq, int* __restrict__ pd, const int lane) {
  int p[16];
#pragma unroll
  for (int i = 0; i < 16; ++i) {
    int acc = __builtin_amdgcn_sdot4((int)u[i].x, (int)xq.x, 0, false);
    acc = __builtin_amdgcn_sdot4((int)u[i].y, (int)xq.y, acc, false);
    acc = __builtin_amdgcn_sdot4((int)u[i].z, (int)xq.z, acc, false);
    p[i] = __builtin_amdgcn_sdot4((int)u[i].w, (int)xq.w, acc, false);
  }
  int q8[8], q4[4], q2[2];
  const bool b2 = lane & 4, b1 = lane & 2, b0 = lane & 1;
#pragma unroll
  for (int j = 0; j < 8; ++j) { const int keep = b2 ? p[8 + j] : p[j], send = b2 ? p[j] : p[8 + j]; q8[j] = keep + __shfl_xor(send, 4, 64); }
#pragma unroll
  for (int j = 0; j < 4; ++j) { const int keep = b1 ? q8[4 + j] : q8[j], send = b1 ? q8[j] : q8[4 + j]; q4[j] = keep + __shfl_xor(send, 2, 64); }
#pragma unroll
  for (int j = 0; j < 2; ++j) { const int keep = b0 ? q4[2 + j] : q4[j], send = b0 ? q4[j] : q4[2 + j]; q2[j] = keep + __shfl_xor(send, 1, 64); }
  const int slot0 = 16 * (lane & 7) + (lane >> 3);
  pd[slot0] = q2[0];
  pd[slot0 + 8] = q2[1];
}
DI void phase_eu(const Params& p, const unsigned my_xcc, const unsigned my_rank) {
  const unsigned char* h1f8 = p.ws + WS_H1F8;
  const unsigned char* ub8 = p.ws + WS_UB;
  const int* sel_i = (const int*)(p.ws + WS_SELI);
  int* pdot = (int*)(p.ws + WS_PDOT);
  const int lane = threadIdx.x & 63, w = __builtin_amdgcn_readfirstlane(threadIdx.x >> 6);
  const SliceOwner so = read_census(p, my_xcc);
#pragma unroll 1
  for (int cs = 0; cs < 8; ++cs) {
    if (!((so.mine >> cs) & 1u)) continue;
    const int nblk = so.nblk;
    int* pd = pdot + (size_t)cs * T * 128;
    if ((int)my_rank >= T / 8) continue;
    const int K = (T / 8 - (int)my_rank + nblk - 1) / nblk;
#define TOK(k) (((int)my_rank + ((k) < K ? (k) : K - 1) * nblk) * 8 + w)
#define EU_IDS(t, i0, i1, xq) do { i0 = sel_i[(size_t)(t) * 128 + lane]; i1 = sel_i[(size_t)(t) * 128 + 64 + lane]; \
                                   xq = *(const uint4*)(h1f8 + (size_t)(t) * 1024 + 128 * cs + 16 * (lane & 7)); } while (0)
    int tA = TOK(0), tB = TOK(1);
    int a0, a1, b0, b1; uint4 xa, xb;
    EU_IDS(tA, a0, a1, xa);
    EU_IDS(tB, b0, b1, xb);
    uint4 uA[16], uB[16];
    eu_load(ub8, a0, a1, cs, lane, uA);
    for (int k = 0; k < K; k += 2) {
      eu_load(ub8, b0, b1, cs, lane, uB);
      const int tA2 = TOK(k + 2); int na0, na1; uint4 nxa;
      EU_IDS(tA2, na0, na1, nxa);
      eu_compute(uA, xa, pd + (size_t)tA * 128, lane);
      eu_load(ub8, na0, na1, cs, lane, uA);
      const int tB2 = TOK(k + 3); int nb0, nb1; uint4 nxb;
      EU_IDS(tB2, nb0, nb1, nxb);
      eu_compute(uB, xb, pd + (size_t)tB * 128, lane);
      tA = tA2; a0 = na0; a1 = na1; xa = nxa; tB = tB2; b0 = nb0; b1 = nb1; xb = nxb;
    }
#undef EU_IDS
  }
}

DI void phase_ec(const Params& p) {
  const int* pdot = (const int*)(p.ws + WS_PDOT);
  const float* sel_g = (const float*)(p.ws + WS_SELG);
  const int* sel_i = (const int*)(p.ws + WS_SELI);
  const float* su = (const float*)(p.ws + WS_SU);
  const float* sx = (const float*)(p.ws + WS_SX);
  float* cbuf = (float*)(p.ws + WS_CBUF);
  const size_t gsz = (size_t)gridDim.x * NT, n = (size_t)T * 128;
  size_t i = (size_t)blockIdx.x * NT + threadIdx.x;
  for (; i + gsz < n; i += 2 * gsz) {
    int d[2] = {0, 0}; int id[2]; float g[2], s2[2];
#pragma unroll
    for (int z = 0; z < 2; ++z) {
      const size_t e = i + z * gsz;
#pragma unroll
      for (int cs = 0; cs < 8; ++cs) d[z] += pdot[(size_t)cs * T * 128 + e];
      id[z] = sel_i[e]; g[z] = sel_g[e]; s2[z] = sx[e >> 7];
    }
#pragma unroll
    for (int z = 0; z < 2; ++z) {
      const float xx = (float)d[z] * su[id[z]] * s2[z];
      const float act = 0.5f * xx * (1.f + erff(xx * 0.70710678118654752f));
      cbuf[i + z * gsz] = act * g[z] * (1.f / V_SCALE);
    }
  }
  for (; i < n; i += gsz) {
    int d = 0;
#pragma unroll
    for (int cs = 0; cs < 8; ++cs) d += pdot[(size_t)cs * T * 128 + i];
    const float xx = (float)d * su[sel_i[i]] * sx[i >> 7];
    const float act = 0.5f * xx * (1.f + erff(xx * 0.70710678118654752f));
    cbuf[i] = act * sel_g[i] * (1.f / V_SCALE);
  }
}

DI void ev_load(const unsigned char* __restrict__ vb8, const int id0, const int id1, const int cs, const int lane, uint4 (&v)[16]) {
#pragma unroll
  for (int i = 0; i < 16; ++i) {
    const int id = __shfl(i < 8 ? id0 : id1, (8 * i + (lane >> 3)) & 63, 64);
    v[i] = *(const uint4*)(vb8 + (size_t)id * 1024 + 128 * cs + 16 * (lane & 7));
  }
}
DI void ev_compute(const uint4 (&v)[16], const float c0, const float c1, float* __restrict__ yrow, const int lane) {
  f32x2 acc[8];
#pragma unroll
  for (int k = 0; k < 8; ++k) acc[k] = f32x2{0.f, 0.f};
#pragma unroll
  for (int i = 0; i < 16; ++i) {
    const float c = __shfl(i < 8 ? c0 : c1, (8 * i + (lane >> 3)) & 63, 64);
    const f32x2 cc = f32x2{c, c};
    f32x2 vf[8];
    fp8x16_to_f32(v[i], vf);
#pragma unroll
    for (int k = 0; k < 8; ++k) acc[k] = __builtin_elementwise_fma(vf[k], cc, acc[k]);
  }
  float a[16];
#pragma unroll
  for (int k = 0; k < 8; ++k) { a[2 * k] = acc[k][0]; a[2 * k + 1] = acc[k][1]; }
  float q8[8], q4[4], q2[2];
  const bool b5 = lane & 32, b4 = lane & 16, b3 = lane & 8;
#pragma unroll
  for (int j = 0; j < 8; ++j) { const float keep = b5 ? a[8 + j] : a[j], send = b5 ? a[j] : a[8 + j]; q8[j] = keep + __shfl_xor(send, 32, 64); }
#pragma unroll
  for (int j = 0; j < 4; ++j) { const float keep = b4 ? q8[4 + j] : q8[j], send = b4 ? q8[j] : q8[4 + j]; q4[j] = keep + __shfl_xor(send, 16, 64); }
#pragma unroll
  for (int j = 0; j < 2; ++j) { const float keep = b3 ? q4[2 + j] : q4[j], send = b3 ? q4[j] : q4[2 + j]; q2[j] = keep + __shfl_xor(send, 8, 64); }
  *(float2*)(yrow + 16 * (lane & 7) + 2 * (lane >> 3)) = float2{q2[0], q2[1]};
}

DI void phase_ev(const Params& p, const unsigned my_xcc, const unsigned my_rank) {
  const unsigned char* vb8 = p.ws + WS_VB;
  const int* sel_i = (const int*)(p.ws + WS_SELI);
  const float* cbuf = (const float*)(p.ws + WS_CBUF);
  float* ybuf = (float*)(p.ws + WS_YBUF);
  const int lane = threadIdx.x & 63, w = __builtin_amdgcn_readfirstlane(threadIdx.x >> 6);
  const SliceOwner so = read_census(p, my_xcc);
#pragma unroll 1
  for (int cs = 0; cs < 8; ++cs) {
    if (!((so.mine >> cs) & 1u)) continue;
    const int nblk = so.nblk;
    if ((int)my_rank >= T / 8) continue;
    const int K = (T / 8 - (int)my_rank + nblk - 1) / nblk;
#define EV_IDS(t, i0, i1, c0, c1) do { i0 = sel_i[(size_t)(t) * 128 + lane]; i1 = sel_i[(size_t)(t) * 128 + 64 + lane]; \
                                       c0 = cbuf[(size_t)(t) * 128 + lane]; c1 = cbuf[(size_t)(t) * 128 + 64 + lane]; } while (0)
    int tA = TOK(0), tB = TOK(1);
    int a0, a1, b0, b1; float ca0, ca1, cb0, cb1;
    EV_IDS(tA, a0, a1, ca0, ca1);
    EV_IDS(tB, b0, b1, cb0, cb1);
    uint4 vA[16], vB[16];
    ev_load(vb8, a0, a1, cs, lane, vA);
    for (int k = 0; k < K; k += 2) {
      ev_load(vb8, b0, b1, cs, lane, vB);
      const int tA2 = TOK(k + 2); int na0, na1; float nca0, nca1;
      EV_IDS(tA2, na0, na1, nca0, nca1);
      ev_compute(vA, ca0, ca1, ybuf + (size_t)tA * 1024 + 128 * cs, lane);
      ev_load(vb8, na0, na1, cs, lane, vA);
      const int tB2 = TOK(k + 3); int nb0, nb1; float ncb0, ncb1;
      EV_IDS(tB2, nb0, nb1, ncb0, ncb1);
      ev_compute(vB, cb0, cb1, ybuf + (size_t)tB * 1024 + 128 * cs, lane);
      tA = tA2; a0 = na0; a1 = na1; ca0 = nca0; ca1 = nca1; tB = tB2; b0 = nb0; b1 = nb1; cb0 = ncb0; cb1 = ncb1;
    }
#undef EV_IDS
#undef TOK
  }
}

DI void phase_ln2(const Params& p) {
  const float* ybuf = (const float*)(p.ws + WS_YBUF);
  const u16* h1b = (const u16*)(p.ws + WS_XB);
  const int lane = threadIdx.x & 63, w = __builtin_amdgcn_readfirstlane(threadIdx.x >> 6);
  float4 gg[4], bb[4];
#pragma unroll
  for (int k = 0; k < 4; ++k) { gg[k] = *(const float4*)(p.ln2_g + 256 * k + 4 * lane); bb[k] = *(const float4*)(p.ln2_b + 256 * k + 4 * lane); }
  for (int tb = blockIdx.x; tb < T / 8; tb += 2 * gridDim.x) {
    const int tb1 = tb + (int)gridDim.x < T / 8 ? tb + (int)gridDim.x : tb;
    const int tt[2] = {tb * 8 + w, tb1 * 8 + w};
    float4 v[2][4];
#pragma unroll
    for (int z = 0; z < 2; ++z)
#pragma unroll
      for (int k = 0; k < 4; ++k) {
        const uint2 hq = *(const uint2*)(h1b + (size_t)tt[z] * 1024 + 256 * k + 4 * lane);
        const float4 y = *(const float4*)(ybuf + (size_t)tt[z] * 1024 + 256 * k + 4 * lane);
        v[z][k] = float4{ALPHA * bflo(hq.x) + y.x, ALPHA * bfhi(hq.x) + y.y, ALPHA * bflo(hq.y) + y.z, ALPHA * bfhi(hq.y) + y.w};
      }
#pragma unroll
    for (int z = 0; z < 2; ++z) {
      float sm = 0.f;
#pragma unroll
      for (int k = 0; k < 4; ++k) sm += v[z][k].x + v[z][k].y + v[z][k].z + v[z][k].w;
      const float mean = wave_sum(sm) * (1.f / 1024.f);
      float sq = 0.f;
#pragma unroll
      for (int k = 0; k < 4; ++k) { float d; d = v[z][k].x - mean; sq += d * d; d = v[z][k].y - mean; sq += d * d; d = v[z][k].z - mean; sq += d * d; d = v[z][k].w - mean; sq += d * d; }
      const float rstd = rsqrtf(wave_sum(sq) * (1.f / 1024.f) + LN_EPS);
#pragma unroll
      for (int k = 0; k < 4; ++k) {
        float4 o;
        o.x = (v[z][k].x - mean) * rstd * gg[k].x + bb[k].x; o.y = (v[z][k].y - mean) * rstd * gg[k].y + bb[k].y;
        o.z = (v[z][k].z - mean) * rstd * gg[k].z + bb[k].z; o.w = (v[z][k].w - mean) * rstd * gg[k].w + bb[k].w;
        *(float4*)(p.out + (size_t)tt[z] * 1024 + 256 * k + 4 * lane) = o;
      }
    }
  }
}

DI void grid_barrier(unsigned* ctr, unsigned target) {
  asm volatile("s_waitcnt vmcnt(0)" ::: "memory");
  __syncthreads();
  if (threadIdx.x == 0) {
    __builtin_amdgcn_fence(__ATOMIC_RELEASE, "agent");
    asm volatile("s_waitcnt vmcnt(0)" ::: "memory");
    (void)__hip_atomic_fetch_add(ctr, 1u, __ATOMIC_RELAXED, __HIP_MEMORY_SCOPE_AGENT);
    unsigned spins = 0;
    while (__hip_atomic_load(ctr, __ATOMIC_RELAXED, __HIP_MEMORY_SCOPE_AGENT) < target) {
      __builtin_amdgcn_s_sleep(1);
      if (++spins > (1u << 24)) break;
    }
    __builtin_amdgcn_fence(__ATOMIC_ACQUIRE, "agent");
    asm volatile("s_waitcnt vmcnt(0)" ::: "memory");
  }
  __syncthreads();
}

DI void grid_barrier_xcd(unsigned* bar, const unsigned gen, const unsigned my_xcc, const unsigned n_local, const unsigned n_xcds) {
  asm volatile("s_waitcnt vmcnt(0)" ::: "memory");
  __syncthreads();
  if (threadIdx.x == 0) {
    unsigned* xcnt = bar + 768 + 32 * my_xcc;
    unsigned* top = bar + 640;
    unsigned* rel = bar + 704;
    const unsigned old = __hip_atomic_fetch_add(xcnt, 1u, __ATOMIC_RELAXED, __HIP_MEMORY_SCOPE_AGENT);
    unsigned* xrel = bar + 96 + 64 * my_xcc;
    unsigned spins = 0;
    if (old + 1u == gen * n_local) {
      __builtin_amdgcn_fence(__ATOMIC_RELEASE, "agent");
      asm volatile("s_waitcnt vmcnt(0)" ::: "memory");
      const unsigned t = __hip_atomic_fetch_add(top, 1u, __ATOMIC_RELAXED, __HIP_MEMORY_SCOPE_AGENT);
      if (t + 1u == gen * n_xcds) __hip_atomic_store(rel, gen, __ATOMIC_RELAXED, __HIP_MEMORY_SCOPE_AGENT);
      while (__hip_atomic_load(rel, __ATOMIC_RELAXED, __HIP_MEMORY_SCOPE_AGENT) < gen) {
        __builtin_amdgcn_s_sleep(1);
        if (++spins > (1u << 24)) break;
      }
      __hip_atomic_store(xrel, gen, __ATOMIC_RELAXED, __HIP_MEMORY_SCOPE_AGENT);
    } else {
      while (__hip_atomic_load(xrel, __ATOMIC_RELAXED, __HIP_MEMORY_SCOPE_AGENT) < gen) {
        __builtin_amdgcn_s_sleep(1);
        if (++spins > (1u << 24)) break;
      }
    }
    __builtin_amdgcn_fence(__ATOMIC_ACQUIRE, "agent");
    asm volatile("s_waitcnt vmcnt(0)" ::: "memory");
  }
  __syncthreads();
}

__global__ void __launch_bounds__(NT) hymba_fwd(Params p) {
  extern __shared__ __attribute__((aligned(16))) char smem[];
  const int lo = p.ph_lo, hi = p.ph_hi;
  const unsigned my_xcc = xcc_id() & 7u;
  unsigned my_rank = 0;
  if (threadIdx.x == 0) {
    my_rank = __hip_atomic_fetch_add((unsigned*)(p.ws + WS_BAR) + 64 + 64 * my_xcc, 1u, __ATOMIC_RELAXED, __HIP_MEMORY_SCOPE_AGENT);
    (void)__hip_atomic_fetch_add((unsigned*)(p.ws + WS_BAR) + 576, 1u, __ATOMIC_RELAXED, __HIP_MEMORY_SCOPE_AGENT);
  }
  if (threadIdx.x == 0) *(unsigned*)smem = my_rank;
  __syncthreads();
  my_rank = *(const unsigned*)smem;
  __syncthreads();
#define IN(k) (lo <= (k) && (k) < hi)
  unsigned bar_target = 0;
  unsigned xgen = 0, n_local = 0, n_xcds = 0;
#define SEAM(k) do { if (IN(k) && IN((k) + 1)) { \
    if (n_local == 0) { \
      if (threadIdx.x == 0) { unsigned sp_ = 0; while (ld_agent((const unsigned*)(p.ws + WS_BAR) + 576) < gridDim.x) { __builtin_amdgcn_s_sleep(1); if (++sp_ > (1u << 24)) break; } } \
      __syncthreads(); \
      _Pragma("unroll") for (int x_ = 0; x_ < 8; ++x_) { const unsigned c_ = ld_agent((const unsigned*)(p.ws + WS_BAR) + 64 + 64 * x_); n_xcds += c_ > 0; if ((unsigned)x_ == my_xcc) n_local = c_; } \
    } \
    ++xgen; grid_barrier_xcd((unsigned*)(p.ws + WS_BAR), xgen, my_xcc, n_local, n_xcds); } } while (0)
  if (IN(0)) {
    const size_t gtid = (size_t)blockIdx.x * NT + threadIdx.x, gsz = (size_t)gridDim.x * NT;
    cvt_linear(p.x, (u16*)(p.ws + WS_XB), (size_t)T * DM / 8, gtid, gsz);
    {
      u16* kd = (u16*)(p.ws + WS_KEYS);
      for (size_t i = gtid; i < (size_t)8 * 2 * 128 * 16; i += gsz) {
        const int c8 = (int)(i & 15), n = (int)((i >> 4) & 127), hp = (int)(i >> 11);
        const float4 a = *(const float4*)(p.keys + i * 8), b = *(const float4*)(p.keys + i * 8 + 4);
        *(uint4*)(kd + ((size_t)((hp * 4 + (c8 >> 2)) * 4 + (c8 & 3)) * 128 + n) * 8) = cvt8(a, b);
      }
    }
    cvt_transpose(p.w_in, (u16*)(p.ws + WS_WIN), DM, NPROJ, gtid, gsz);
  }
  SEAM(0);
  if (IN(1)) phase_inproj(p, smem);
  SEAM(1);
  if (IN(2)) { phase_attn(p, smem); phase_conv(p, smem); }
  SEAM(2);
  if (IN(3)) phase_outproj(p, smem);
  SEAM(3);
  if (IN(4)) phase_ln1(p);
  SEAM(4);
  if (IN(5)) phase_peer_q(p, smem);
  SEAM(5);
  if (IN(6)) phase_eu(p, my_xcc, my_rank);
  SEAM(6);
  if (IN(7)) phase_ec(p);
  SEAM(7);
  if (IN(8)) phase_ev(p, my_xcc, my_rank);
  SEAM(8);
  if (IN(9)) phase_ln2(p);
#undef IN
#undef SEAM
}

extern "C" void kernel_launch(void* const* d_in, const int* in_sizes, int n_in, void* d_out, int out_size, void* d_ws, size_t ws_size, hipStream_t stream) {
  static int grid = 0;
  if (grid == 0) {
    int dev = 0, cus = 0, per_cu = 0;
    hipGetDevice(&dev);
    hipDeviceGetAttribute(&cus, hipDeviceAttributeMultiprocessorCount, dev);
    hipFuncSetAttribute((const void*)hymba_fwd, hipFuncAttributeMaxDynamicSharedMemorySize, LDS_BYTES);
    if (hipOccupancyMaxActiveBlocksPerMultiprocessor(&per_cu, (const void*)hymba_fwd, NT, LDS_BYTES) != hipSuccess || per_cu < 1) {
      fprintf(stderr, "kernel_launch: occupancy query gave %d blocks per CU\n", per_cu); per_cu = 1;
    }
    (void)hipGetLastError();
    if (per_cu > 1) per_cu = 1;
    grid = cus * per_cu;
    if (ws_size < WS_END) fprintf(stderr, "kernel_launch: workspace too small: %zu < %zu\n", ws_size, (size_t)WS_END);
  }
  Params p{};
  p.x = (const float*)d_in[0]; p.w_in = (const float*)d_in[1]; p.b_in = (const float*)d_in[2]; p.conv_w = (const float*)d_in[3];
  p.conv_b = (const float*)d_in[4]; p.cln_g = (const float*)d_in[5]; p.cln_b = (const float*)d_in[6]; p.w_out = (const float*)d_in[7];
  p.b_out = (const float*)d_in[8]; p.ln1_g = (const float*)d_in[9]; p.ln1_b = (const float*)d_in[10]; p.wq = (const float*)d_in[11];
  p.keys = (const float*)d_in[12]; p.ut = (const float*)d_in[13]; p.vt = (const float*)d_in[14]; p.ln2_g = (const float*)d_in[15];
  p.ln2_b = (const float*)d_in[16];
  p.out = (float*)d_out; p.ws = (unsigned char*)d_ws;
  p.ph_lo = 0; p.ph_hi = 10;
  (void)hipMemsetAsync((unsigned char*)d_ws + WS_BAR, 0, 4096, stream);
  hipLaunchKernelGGL(hymba_fwd, dim3(grid), dim3(NT), LDS_BYTES, stream, p);
}
```

```cpp
#include <hip/hip_runtime.h>
#include <cstdio>

typedef __attribute__((ext_vector_type(8))) short bf16x8;
typedef __attribute__((ext_vector_type(4))) float f32x4;
typedef unsigned short u16;
#define DI __device__ __forceinline__
#define MFMA16(a, b, c) __builtin_amdgcn_mfma_f32_16x16x32_bf16((a), (b), (c), 0, 0, 0)


constexpr int NT = 512;
constexpr int T = 32768;
constexpr int SEQ = 2048;
constexpr int DM = 1024;
constexpr int NPROJ = 2560;
constexpr float ALPHA = 1.189207115002721f;
constexpr float LN_EPS = 1e-5f;
constexpr float LOG2E = 1.4426950408889634f;
constexpr float V_SCALE = 8.f;

constexpr size_t MB = 1024 * 1024;
constexpr size_t WS_XB = 0;
constexpr size_t WS_WIN = WS_XB + 64 * MB;
constexpr size_t WS_WOUT = WS_WIN + 5 * MB;
constexpr size_t WS_WQ = WS_WOUT + 2 * MB;
constexpr size_t WS_KEYS = WS_WQ + 4 * MB;
constexpr size_t WS_UB = WS_KEYS + 1 * MB;
constexpr size_t WS_VB = WS_UB + 32 * MB;
constexpr size_t WS_PU = WS_VB + 32 * MB;
constexpr size_t WS_Q = WS_PU + 64 * MB;
constexpr size_t WS_K = WS_Q + 32 * MB;
constexpr size_t WS_VT = WS_K + 32 * MB;
constexpr size_t WS_VT4 = WS_VT + 32 * MB;
constexpr size_t WS_VT16 = WS_VT4 + 32 * MB;
constexpr size_t WS_K4 = WS_VT16 + 32 * MB;
constexpr size_t WS_MIX = WS_K4 + 32 * MB;
constexpr size_t WS_H1F8 = WS_MIX;
constexpr size_t WS_CBUF = WS_MIX + 32 * MB;
constexpr size_t WS_PDOT = WS_PU;
constexpr size_t WS_YBUF = WS_PU;
constexpr size_t WS_SELI = WS_MIX + 64 * MB;
constexpr size_t WS_SELG = WS_SELI + 16 * MB;
constexpr size_t WS_K16 = WS_SELI;
constexpr size_t WS_BAR = WS_SELG + 16 * MB;
constexpr size_t WS_SU = WS_BAR + 4096;
constexpr size_t WS_SX = WS_SU + 65536;
constexpr size_t WS_END = WS_SX + 131072;

constexpr int LDS_BYTES = 128 * 257 * 4 + 128 * 2 * 16 * 4;

struct Params {
  const float* x; const float* w_in; const float* b_in; const float* conv_w; const float* conv_b; const float* cln_g; const float* cln_b;
  const float* w_out; const float* b_out; const float* ln1_g; const float* ln1_b; const float* wq; const float* keys; const float* ut; const float* vt;
  const float* ln2_g; const float* ln2_b;
  float* out; unsigned char* ws;
  int ph_lo, ph_hi;
};

typedef float f32x2 __attribute__((ext_vector_type(2)));
typedef __bf16 bf16x2_t __attribute__((ext_vector_type(2)));
DI unsigned pack2(float a, float b) { const f32x2 v = {a, b}; const bf16x2_t r = __builtin_convertvector(v, bf16x2_t); return __builtin_bit_cast(unsigned, r); }
DI u16 f2bf(float x) { return (u16)(pack2(x, x) & 0xffffu); }
DI float bf2f(u16 h) { return __uint_as_float(((unsigned)h) << 16); }
DI float bflo(unsigned w) { return __uint_as_float(w << 16); }
DI float bfhi(unsigned w) { return __uint_as_float(w & 0xffff0000u); }
DI float wave_sum(float v) {
#pragma unroll
  for (int o = 32; o > 0; o >>= 1) v += __shfl_xor(v, o, 64);
  return v;
}
DI uint4 cvt8(const float4 a, const float4 b) { uint4 r; r.x = pack2(a.x, a.y); r.y = pack2(a.z, a.w); r.z = pack2(b.x, b.y); r.w = pack2(b.z, b.w); return r; }

DI void cvt_linear(const float* __restrict__ src, u16* __restrict__ dst, size_t n8, size_t gtid, size_t gsz) {
  for (size_t i = gtid; i < n8; i += gsz) {
    const float4 a = *(const float4*)(src + i * 8), b = *(const float4*)(src + i * 8 + 4);
    *(uint4*)(dst + i * 8) = cvt8(a, b);
  }
}
DI unsigned pk4_fp8(float a, float b, float c, float d) {
  int r = 0;
  r = __builtin_amdgcn_cvt_pk_fp8_f32(a, b, r, false);
  r = __builtin_amdgcn_cvt_pk_fp8_f32(c, d, r, true);
  return (unsigned)r;
}
DI void cvt_linear_fp8(const float* __restrict__ src, unsigned char* __restrict__ dst, size_t n16, float scale, size_t gtid, size_t gsz) {
  for (size_t i = gtid; i < n16; i += gsz) {
    const float4 a = *(const float4*)(src + i * 16), b = *(const float4*)(src + i * 16 + 4), c = *(const float4*)(src + i * 16 + 8), d = *(const float4*)(src + i * 16 + 12);
    uint4 r;
    r.x = pk4_fp8(a.x * scale, a.y * scale, a.z * scale, a.w * scale); r.y = pk4_fp8(b.x * scale, b.y * scale, b.z * scale, b.w * scale);
    r.z = pk4_fp8(c.x * scale, c.y * scale, c.z * scale, c.w * scale); r.w = pk4_fp8(d.x * scale, d.y * scale, d.z * scale, d.w * scale);
    *(uint4*)(dst + i * 16) = r;
  }
}
DI unsigned pk4_i8(float a, float b, float c, float d) {
  const int ia = (int)rintf(a), ib = (int)rintf(b), ic = (int)rintf(c), id = (int)rintf(d);
  return (unsigned)(ia & 255) | ((unsigned)(ib & 255) << 8) | ((unsigned)(ic & 255) << 16) | ((unsigned)(id & 255) << 24);
}
DI void cvt_rows_i8(const float* __restrict__ src, unsigned char* __restrict__ dst, float* __restrict__ scale_out, size_t n16, size_t gtid, size_t gsz) {
  for (size_t i = gtid; i < n16; i += gsz) {
    const float4 a = *(const float4*)(src + i * 16), b = *(const float4*)(src + i * 16 + 4), c = *(const float4*)(src + i * 16 + 8), d = *(const float4*)(src + i * 16 + 12);
    float m = fmaxf(fmaxf(fmaxf(fabsf(a.x), fabsf(a.y)), fmaxf(fabsf(a.z), fabsf(a.w))), fmaxf(fmaxf(fabsf(b.x), fabsf(b.y)), fmaxf(fabsf(b.z), fabsf(b.w))));
    m = fmaxf(m, fmaxf(fmaxf(fmaxf(fabsf(c.x), fabsf(c.y)), fmaxf(fabsf(c.z), fabsf(c.w))), fmaxf(fmaxf(fabsf(d.x), fabsf(d.y)), fmaxf(fabsf(d.z), fabsf(d.w)))));
#pragma unroll
    for (int o = 32; o > 0; o >>= 1) m = fmaxf(m, __shfl_xor(m, o, 64));
    m = fmaxf(m, 1e-30f);
    const float q = 127.f / m;
    uint4 r;
    r.x = pk4_i8(a.x * q, a.y * q, a.z * q, a.w * q); r.y = pk4_i8(b.x * q, b.y * q, b.z * q, b.w * q);
    r.z = pk4_i8(c.x * q, c.y * q, c.z * q, c.w * q); r.w = pk4_i8(d.x * q, d.y * q, d.z * q, d.w * q);
    *(uint4*)(dst + i * 16) = r;
    if ((i & 63) == 0) scale_out[i >> 6] = m * (1.f / 127.f);
  }
}
DI void cvt_transpose(const float* __restrict__ src, u16* __restrict__ dst, int K, int N, size_t gtid, size_t gsz) {
  const size_t total = (size_t)N * (K / 8);
  for (size_t i = gtid; i < total; i += gsz) {
    const int n = (int)(i % N), k8 = (int)(i / N);
    float v[8];
#pragma unroll
    for (int j = 0; j < 8; ++j) v[j] = src[(size_t)(k8 * 8 + j) * N + n];
    uint4 r; r.x = pack2(v[0], v[1]); r.y = pack2(v[2], v[3]); r.z = pack2(v[4], v[5]); r.w = pack2(v[6], v[7]);
    *(uint4*)(dst + (size_t)n * K + k8 * 8) = r;
  }
}

constexpr int STAGE_BYTES = 384 * 128;

typedef __attribute__((address_space(3))) unsigned lds_u32;
template <int WM>
DI void gemm_tile(const u16* __restrict__ A, const u16* __restrict__ Bt, const int K, const int m0, const int n0, char* smem, f32x4 (&acc)[4][4]) {
  constexpr int BM = 64 * WM;
  const int tid = threadIdx.x, lane = tid & 63, w = __builtin_amdgcn_readfirstlane(tid >> 6);
  const int wm = w % WM, wn = w / WM;
  const int g = lane >> 4, r16 = lane & 15;
#pragma unroll
  for (int i = 0; i < 4; ++i)
#pragma unroll
    for (int j = 0; j < 4; ++j) acc[i][j] = f32x4{0.f, 0.f, 0.f, 0.f};
  const int srow = tid >> 3, sc = tid & 7;
  const u16* gp[6];
#pragma unroll
  for (int i = 0; i < 6; ++i) {
    const int row = srow + 64 * i;
    const int c = sc ^ ((row >> 1) & 7);
    gp[i] = (i < WM) ? (A + (size_t)(m0 + row) * K + c * 8) : (Bt + (size_t)(n0 + row - BM) * K + c * 8);
  }
  lds_u32* lbase = (lds_u32*)(smem + tid * 16);
#define STAGE(KOFF, BUF) do { \
    _Pragma("unroll") for (int i = 0; i < 6; ++i) \
      __builtin_amdgcn_global_load_lds((const unsigned*)(gp[i] + (KOFF)), (lds_u32*)((__attribute__((address_space(3))) char*)lbase + (BUF) * STAGE_BYTES + i * 8192), 16, 0, 0); } while (0)
  const int KT = K / 64;
  STAGE(0, 0);
  STAGE(64, 1);
  for (int kt = 0; kt < KT; ++kt) {
    asm volatile("s_waitcnt vmcnt(6)" ::: "memory");
    __builtin_amdgcn_s_barrier();
    const int kn = (kt + 2 < KT ? kt + 2 : KT - 1) * 64;
    const int bn = (kt + 2) % 3, bc = kt % 3;
    STAGE(kn, bn);
    const char* cur = smem + bc * STAGE_BYTES;
    bf16x8 af[2][4], bfr[2][4];
#pragma unroll
    for (int kk = 0; kk < 2; ++kk) {
      const int c = 4 * kk + g;
#pragma unroll
      for (int mi = 0; mi < 4; ++mi) { const int row = 64 * wm + 16 * mi + r16; af[kk][mi] = *(const bf16x8*)(cur + row * 128 + ((c ^ ((row >> 1) & 7)) << 4)); }
#pragma unroll
      for (int ni = 0; ni < 4; ++ni) { const int row = BM + 64 * wn + 16 * ni + r16; bfr[kk][ni] = *(const bf16x8*)(cur + row * 128 + ((c ^ ((row >> 1) & 7)) << 4)); }
    }
#pragma unroll
    for (int kk = 0; kk < 2; ++kk)
#pragma unroll
      for (int mi = 0; mi < 4; ++mi)
#pragma unroll
        for (int ni = 0; ni < 4; ++ni) acc[mi][ni] = MFMA16(af[kk][mi], bfr[kk][ni], acc[mi][ni]);
  }
#undef STAGE
  asm volatile("s_waitcnt vmcnt(0)" ::: "memory");
  __syncthreads();
}

template <int MMG>
DI void tile_coords(const int lin, const int k, const int MT, const int NTN, int& mt, int& nt) {
  const int G = gridDim.x, total = MT * NTN;
  if ((G & 7) == 0 && total % G == 0 && (MT & 7) == 0 && ((MT >> 3) % MMG) == 0) {
    const int x = blockIdx.x & 7, r = blockIdx.x >> 3, q = r + (G >> 3) * k;
    const int mm = q % MMG, rest = q / MMG;
    nt = rest % NTN;
    mt = x * (MT >> 3) + (rest / NTN) * MMG + mm;
  } else { mt = lin / NTN; nt = lin % NTN; }
}

constexpr int CT_PITCH = 132;
DI void stage_acc(const f32x4 (&acc)[4][4], char* smem, const int wm, const int wn, const int g, const int r16) {
  float* ct = (float*)smem;
#pragma unroll
  for (int mi = 0; mi < 4; ++mi)
#pragma unroll
    for (int ni = 0; ni < 4; ++ni)
#pragma unroll
      for (int j = 0; j < 4; ++j) ct[(64 * wm + 16 * mi + 4 * g + j) * CT_PITCH + 64 * wn + 16 * ni + r16] = acc[mi][ni][j];
}

constexpr int BIG_STAGE = 512 * 128;
DI void gemm_tile_big(const u16* __restrict__ A, const u16* __restrict__ Bt, const int K, const int m0, const int n0, char* smem, f32x4 (&acc)[8][4]) {
  const int tid = threadIdx.x, lane = tid & 63, w = __builtin_amdgcn_readfirstlane(tid >> 6);
  const int wm = w & 1, wn = w >> 1;
  const int g = lane >> 4, r16 = lane & 15;
#pragma unroll
  for (int i = 0; i < 8; ++i)
#pragma unroll
    for (int j = 0; j < 4; ++j) acc[i][j] = f32x4{0.f, 0.f, 0.f, 0.f};
  const int srow = tid >> 3, sc = tid & 7;
  const int c = sc ^ ((srow >> 1) & 7);
  const u16* ga = A + (size_t)(m0 + srow) * K + c * 8;
  const u16* gb = Bt + (size_t)(n0 + srow) * K + c * 8;
  const size_t rs = (size_t)64 * K;
  __attribute__((address_space(3))) char* lbase = (__attribute__((address_space(3))) char*)(smem + tid * 16);
#define STAGEB(KOFF, BUF) do { \
    _Pragma("unroll") for (int i = 0; i < 4; ++i) { \
      __builtin_amdgcn_global_load_lds((const unsigned*)(ga + i * rs + (KOFF)), (lds_u32*)(lbase + (BUF) * BIG_STAGE + i * 8192), 16, 0, 0); \
      __builtin_amdgcn_global_load_lds((const unsigned*)(gb + i * rs + (KOFF)), (lds_u32*)(lbase + (BUF) * BIG_STAGE + 32768 + i * 8192), 16, 0, 0); } } while (0)
  const int KT = K / 64;
  STAGEB(0, 0);
  asm volatile("s_waitcnt vmcnt(0)" ::: "memory");
  __builtin_amdgcn_s_barrier();
#pragma unroll 1
  for (int kt = 0; kt < KT; ++kt) {
    STAGEB((kt + 1 < KT ? kt + 1 : kt) * 64, (kt + 1) & 1);
    const char* cur = smem + (kt & 1) * BIG_STAGE;
#pragma unroll
    for (int kk = 0; kk < 2; ++kk) {
      const int cc = 4 * kk + g;
      bf16x8 bfr[4];
#pragma unroll
      for (int ni = 0; ni < 4; ++ni) { const int row = 256 + 64 * wn + 16 * ni + r16; bfr[ni] = *(const bf16x8*)(cur + row * 128 + ((cc ^ ((row >> 1) & 7)) << 4)); }
#pragma unroll
      for (int mi = 0; mi < 8; ++mi) {
        const int row = 128 * wm + 16 * mi + r16;
        const bf16x8 af = *(const bf16x8*)(cur + row * 128 + ((cc ^ ((row >> 1) & 7)) << 4));
#pragma unroll
        for (int ni = 0; ni < 4; ++ni) acc[mi][ni] = MFMA16(af, bfr[ni], acc[mi][ni]);
      }
    }
    asm volatile("s_waitcnt vmcnt(0)" ::: "memory");
    __builtin_amdgcn_s_barrier();
  }
#undef STAGEB
}
template <int HF>
DI void stage_acc_big(const f32x4 (&acc)[8][4], char* smem, const int g, const int r16) {
  const int w = __builtin_amdgcn_readfirstlane(threadIdx.x >> 6), wm = w & 1, wn = w >> 1;
  if ((wn >> 1) != HF) return;
  float* ct = (float*)smem;
#pragma unroll
  for (int mi = 0; mi < 8; ++mi)
#pragma unroll
    for (int ni = 0; ni < 4; ++ni)
#pragma unroll
      for (int j = 0; j < 4; ++j) ct[(128 * wm + 16 * mi + 4 * g + j) * CT_PITCH + 64 * (wn & 1) + 16 * ni + r16] = acc[mi][ni][j];
}

template <int D> DI size_t attn_kidx(int bh, int s, int d) {
  const int r = s % D, l = s / D;
  return ((size_t)((bh * D + r) * (128 / D) + (l >> 4)) * 8 + (d >> 3)) * 128 + (l & 15) * 8 + (d & 7);
}
template <int D> DI size_t attn_vidx(int bh, int s, int d) {
  const int r = s % D, l = s / D;
  return ((size_t)((bh * D + r) * (128 / D) + (l >> 4)) * 64 + d) * 16 + (l & 15);
}

DI void inproj_epilogue(const Params& p, const char* smem, const int m0, const int n0) {
  u16* pu = (u16*)(p.ws + WS_PU); u16* qb = (u16*)(p.ws + WS_Q); u16* kb = (u16*)(p.ws + WS_K); u16* vT = (u16*)(p.ws + WS_VT);
  u16* vT4 = (u16*)(p.ws + WS_VT4); u16* vT16 = (u16*)(p.ws + WS_VT16); u16* k4 = (u16*)(p.ws + WS_K4); u16* k16 = (u16*)(p.ws + WS_K16);
  const float* ct = (const float*)smem;
  if (n0 < 1536) {
    u16* dst = n0 < 1024 ? (pu + (size_t)m0 * 1024 + n0) : (qb + (size_t)m0 * 512 + (n0 - 1024));
    const int ld = n0 < 1024 ? 1024 : 512;
#pragma unroll 4
    for (int i = 0; i < 16; ++i) {
      const int c = threadIdx.x + NT * i, row = c >> 5, ch = c & 31;
      const float4 y = *(const float4*)(ct + row * CT_PITCH + 4 * ch), bv = *(const float4*)(p.b_in + n0 + 4 * ch);
      uint2 r; r.x = pack2(y.x + bv.x, y.y + bv.y); r.y = pack2(y.z + bv.z, y.w + bv.w);
      *(uint2*)(dst + (size_t)row * ld + 4 * ch) = r;
    }
    return;
  }
  const int bbase = (m0 >> 11) * 8, s0 = m0 & 2047;
  if (n0 < 2048) {
    const int cc0 = n0 - 1536;
#pragma unroll 2
    for (int i = 0; i < 8; ++i) {
      const int q = threadIdx.x + NT * i, row = q >> 4, ch16 = q & 15;
      const float4 y0 = *(const float4*)(ct + row * CT_PITCH + 8 * ch16), y1 = *(const float4*)(ct + row * CT_PITCH + 8 * ch16 + 4);
      const float4 b0 = *(const float4*)(p.b_in + n0 + 8 * ch16), b1 = *(const float4*)(p.b_in + n0 + 8 * ch16 + 4);
      uint4 r; r.x = pack2(y0.x + b0.x, y0.y + b0.y); r.y = pack2(y0.z + b0.z, y0.w + b0.w); r.z = pack2(y1.x + b1.x, y1.y + b1.y); r.w = pack2(y1.z + b1.z, y1.w + b1.w);
      const int cc = cc0 + 8 * ch16, bh = bbase + (cc >> 6), d = cc & 63, s = s0 + row;
      *(uint4*)(kb + attn_kidx<1>(bh, s, d)) = r;
      *(uint4*)(k4 + attn_kidx<4>(bh, s, d)) = r;
      *(uint4*)(k16 + attn_kidx<16>(bh, s, d)) = r;
    }
  } else {
    const int cc0 = n0 - 2048;
#pragma unroll 2
    for (int i = 0; i < 8; ++i) {
      const int q = threadIdx.x + NT * i, col = q & 127, cidx = q >> 7;
      const float bias = p.b_in[n0 + col];
      const int cc = cc0 + col, bh = bbase + (cc >> 6), d = cc & 63;
#define V_CHUNK(D, DST) do { \
        const int r_ = cidx % (D), l8_ = (cidx / (D)) * 8; \
        float e_[8]; \
        _Pragma("unroll") for (int j = 0; j < 8; ++j) e_[j] = ct[((D) * (l8_ + j) + r_) * CT_PITCH + col] + bias; \
        uint4 w_; w_.x = pack2(e_[0], e_[1]); w_.y = pack2(e_[2], e_[3]); w_.z = pack2(e_[4], e_[5]); w_.w = pack2(e_[6], e_[7]); \
        *(uint4*)((DST) + attn_vidx<D>(bh, s0 + (D) * l8_ + r_, d)) = w_; } while (0)
      V_CHUNK(1, vT);
      V_CHUNK(4, vT4);
      V_CHUNK(16, vT16);
#undef V_CHUNK
    }
  }
}

DI void phase_inproj(const Params& p, char* smem) {
  const u16* xb = (const u16*)(p.ws + WS_XB);
  const u16* wt = (const u16*)(p.ws + WS_WIN);
  const int lane = threadIdx.x & 63, g = lane >> 4, r16 = lane & 15;
  const int NTN = NPROJ / 256;
  for (int tile = blockIdx.x, kit = 0; tile < (T / 256) * NTN; tile += gridDim.x, ++kit) {
    int mt_, nt_; tile_coords<4>(tile, kit, T / 256, NTN, mt_, nt_);
    const int m0 = mt_ * 256, n0 = nt_ * 256;
    {
      const size_t vt_ = (size_t)tile * NT + threadIdx.x, vsz_ = (size_t)(T / 256) * NTN * NT;
      cvt_transpose(p.w_out, (u16*)(p.ws + WS_WOUT), DM, DM, vt_, vsz_);
      cvt_transpose(p.wq, (u16*)(p.ws + WS_WQ), DM, 2048, vt_, vsz_);
    }
    f32x4 acc[8][4];
    gemm_tile_big(xb, wt, DM, m0, n0, smem, acc);
    stage_acc_big<0>(acc, smem, g, r16);
    __syncthreads();
    inproj_epilogue(p, smem, m0, n0);
    __syncthreads();
    stage_acc_big<1>(acc, smem, g, r16);
    __syncthreads();
    inproj_epilogue(p, smem, m0, n0 + 128);
    __syncthreads();
  }
}

template <int D>
DI void attn_task2(const u16* __restrict__ qb, const u16* __restrict__ kd, const u16* __restrict__ vTd, const int b, const int h,
                   const int rA, const int l0A, const int rB, const int l0B, const float c2, f32x4 (&O)[2][4], float (&m_out)[2], float (&l_out)[2]) {
  const int lane = threadIdx.x & 63, g = lane >> 4, i16 = lane & 15;
  const float c1 = 0.125f * LOG2E;
  const float c2d = c2 * (float)D;
  int nsteps = (l0A + 16 + 31) >> 5;
  nsteps = nsteps > 5 ? 5 : nsteps;
  int l0[2] = {l0A, l0B}, lq[2], first[2], bhr[2];
  bf16x8 qf[2][2];
  float m[2] = {-1e30f, -1e30f}, l[2] = {0.f, 0.f};
#pragma unroll
  for (int z = 0; z < 2; ++z) {
    const int r = z ? rB : rA;
    lq[z] = l0[z] + i16;
    const int tq = D * lq[z] + r;
#pragma unroll
    for (int kk = 0; kk < 2; ++kk) qf[z][kk] = *(const bf16x8*)(qb + (size_t)(b * SEQ + tq) * 512 + h * 64 + 8 * g + 32 * kk);
#pragma unroll
    for (int c = 0; c < 4; ++c) O[z][c] = f32x4{0.f, 0.f, 0.f, 0.f};
    first[z] = l0[z] + 16 - 32 * nsteps;
    bhr[z] = ((b * 8 + h) * D + r) * (128 / D);
  }
  bf16x8 kf[2][2][2], vf[2][4];
#define ATTN_LOAD(Z, LK0, KF, VF) do { \
    const int g0_ = (LK0) >> 4; \
    _Pragma("unroll") for (int u = 0; u < 2; ++u) { \
      const int sl_ = 8 * (i16 >> 2) + 4 * u + (i16 & 3); \
      int gk_ = g0_ + (sl_ >> 4); gk_ = gk_ < 0 ? 0 : gk_; \
      const u16* kp_ = kd + ((size_t)(bhr[Z] + gk_) * 8 + g) * 128 + (sl_ & 15) * 8; \
      _Pragma("unroll") for (int kk = 0; kk < 2; ++kk) KF[u][kk] = *(const bf16x8*)(kp_ + (size_t)kk * 512); \
    } \
    { int gv_ = g0_ + (g >> 1); gv_ = gv_ < 0 ? 0 : gv_; \
      const u16* vp_ = vTd + ((size_t)(bhr[Z] + gv_) * 64 + i16) * 16 + 8 * (g & 1); \
      _Pragma("unroll") for (int c = 0; c < 4; ++c) VF[c] = *(const bf16x8*)(vp_ + c * 256); } \
  } while (0)
  for (int st = 0; st < nsteps; ++st) {
    ATTN_LOAD(0, first[0] + 32 * st, kf[0], vf[0]);
    ATTN_LOAD(1, first[1] + 32 * st, kf[1], vf[1]);
#pragma unroll
    for (int z = 0; z < 2; ++z) {
      const int lk0 = first[z] + 32 * st;
      f32x4 sa[2];
#pragma unroll
      for (int u = 0; u < 2; ++u) {
        sa[u] = MFMA16(kf[z][u][0], qf[z][0], (f32x4{0.f, 0.f, 0.f, 0.f}));
        sa[u] = MFMA16(kf[z][u][1], qf[z][1], sa[u]);
      }
      float s[8];
      float mx = -1e30f;
      const bool interior = (lk0 >= 0) && (l0[z] - lk0 >= 31) && (l0[z] + 15 - lk0 <= 128);
      const float dl0 = (float)(lq[z] - lk0 - 8 * g);
      if (interior) {
#pragma unroll
        for (int u = 0; u < 2; ++u)
#pragma unroll
          for (int j = 0; j < 4; ++j) {
            const float sv = sa[u][j] * c1 - c2d * (dl0 - (float)(4 * u + j));
            s[4 * u + j] = sv;
            mx = fmaxf(mx, sv);
          }
      } else {
#pragma unroll
        for (int u = 0; u < 2; ++u)
#pragma unroll
          for (int j = 0; j < 4; ++j) {
            const int lk = lk0 + 8 * g + 4 * u + j;
            const int dl = lq[z] - lk;
            const bool valid = (dl >= 0) && (dl <= 128) && (lk >= 0);
            const float sv = valid ? (sa[u][j] * c1 - c2d * (float)dl) : -1e30f;
            s[4 * u + j] = sv;
            mx = fmaxf(mx, sv);
          }
      }
      mx = fmaxf(mx, __shfl_xor(mx, 16, 64));
      mx = fmaxf(mx, __shfl_xor(mx, 32, 64));
      const float mn = fmaxf(m[z], mx);
      const float al = __builtin_amdgcn_exp2f(m[z] - mn);
      m[z] = mn;
      float ps = 0.f;
      float pv[8];
      if (interior) {
#pragma unroll
        for (int e = 0; e < 8; ++e) { pv[e] = __builtin_amdgcn_exp2f(s[e] - mn); ps += pv[e]; }
      } else {
#pragma unroll
        for (int e = 0; e < 8; ++e) { pv[e] = (s[e] > -1e29f) ? __builtin_amdgcn_exp2f(s[e] - mn) : 0.f; ps += pv[e]; }
      }
      l[z] = l[z] * al + ps;
#pragma unroll
      for (int c = 0; c < 4; ++c) O[z][c] = O[z][c] * al;
      union { bf16x8 v; unsigned u[4]; } pf;
      pf.u[0] = pack2(pv[0], pv[1]); pf.u[1] = pack2(pv[2], pv[3]); pf.u[2] = pack2(pv[4], pv[5]); pf.u[3] = pack2(pv[6], pv[7]);
#pragma unroll
      for (int c = 0; c < 4; ++c) O[z][c] = MFMA16(vf[z][c], pf.v, O[z][c]);
    }
  }
#undef ATTN_LOAD
#pragma unroll
  for (int z = 0; z < 2; ++z) {
    float lz = l[z];
    lz += __shfl_xor(lz, 16, 64);
    lz += __shfl_xor(lz, 32, 64);
    m_out[z] = m[z]; l_out[z] = lz;
  }
}

constexpr int AST_PITCH = 68;
DI float* ast_ptr(float* Ost, int pos, int c, int g) { return Ost + pos * AST_PITCH + 4 * ((4 * c + g) ^ ((pos >> 4) & 15)); }

DI void phase_attn(const Params& p, char* smem) {
  const u16* qb = (const u16*)(p.ws + WS_Q); const u16* kb = (const u16*)(p.ws + WS_K);
  const u16* vT1 = (const u16*)(p.ws + WS_VT); const u16* vT4 = (const u16*)(p.ws + WS_VT4); const u16* vT16 = (const u16*)(p.ws + WS_VT16);
  const u16* k4 = (const u16*)(p.ws + WS_K4); const u16* k16 = (const u16*)(p.ws + WS_K16);
  u16* mix = (u16*)(p.ws + WS_MIX);
  float* Ost = (float*)smem; float* mst = Ost + 256 * AST_PITCH; float* lst = mst + 256;
  const int lane = threadIdx.x & 63, w = __builtin_amdgcn_readfirstlane(threadIdx.x >> 6), g = lane >> 4, i16 = lane & 15;
  for (int item = blockIdx.x; item < 1024; item += gridDim.x) {
    {
      const size_t vt_ = (size_t)item * NT + threadIdx.x, vsz_ = (size_t)1024 * NT;
      cvt_rows_i8(p.ut, p.ws + WS_UB, (float*)(p.ws + WS_SU), (size_t)16384 * DM / 16, vt_, vsz_);
      cvt_linear_fp8(p.vt, p.ws + WS_VB, (size_t)16384 * DM / 16, V_SCALE, vt_, vsz_);
    }
    const int qblk = 7 - (item >> 7), bh = item & 127, b = bh >> 3, h = bh & 7;
    const int t0 = qblk * 256;
    const float c2 = exp2f(-(float)(h + 1)) * LOG2E;
    {
      f32x4 O[2][4]; float m[2], l[2];
      attn_task2<1>(qb, kb, vT1, b, h, 0, t0 + 32 * w, 0, t0 + 32 * w + 16, c2, O, m, l);
#pragma unroll
      for (int z = 0; z < 2; ++z) {
        const int pos = 16 * (2 * w + z) + i16;
#pragma unroll
        for (int c = 0; c < 4; ++c) *(f32x4*)ast_ptr(Ost, pos, c, g) = O[z][c];
        if (g == 0) { mst[pos] = m[z]; lst[pos] = l[z]; }
      }
    }
    __syncthreads();
    {
      const int i = (2 * w) >> 2, r0 = (2 * w) & 3;
      f32x4 O[2][4]; float m[2], l[2];
      attn_task2<4>(qb, k4, vT4, b, h, r0, (t0 >> 2) + 16 * i, r0 + 1, (t0 >> 2) + 16 * i, c2, O, m, l);
#pragma unroll
      for (int z = 0; z < 2; ++z) {
        const int pos = 64 * i + 4 * i16 + r0 + z;
        const float mo = mst[pos], lo = lst[pos];
        const float mn = fmaxf(mo, m[z]), ao = __builtin_amdgcn_exp2f(mo - mn), an = __builtin_amdgcn_exp2f(m[z] - mn);
#pragma unroll
        for (int c = 0; c < 4; ++c) { float* q = ast_ptr(Ost, pos, c, g); const f32x4 old = *(const f32x4*)q; *(f32x4*)q = old * ao + O[z][c] * an; }
        if (g == 0) { mst[pos] = mn; lst[pos] = lo * ao + l[z] * an; }
      }
    }
    __syncthreads();
    {
      f32x4 O[2][4]; float m[2], l[2];
      attn_task2<16>(qb, k16, vT16, b, h, 2 * w, t0 >> 4, 2 * w + 1, t0 >> 4, c2, O, m, l);
#pragma unroll
      for (int z = 0; z < 2; ++z) {
        const int pos = 16 * i16 + 2 * w + z;
        const float mo = mst[pos], lo = lst[pos];
        const float mn = fmaxf(mo, m[z]), ao = __builtin_amdgcn_exp2f(mo - mn), an = __builtin_amdgcn_exp2f(m[z] - mn);
        const float inv = 1.f / (lo * ao + l[z] * an);
        u16* orow = mix + (size_t)(b * SEQ + t0 + pos) * 1024 + 512 + h * 64 + 4 * g;
#pragma unroll
        for (int c = 0; c < 4; ++c) {
          const f32x4 old = *(const f32x4*)ast_ptr(Ost, pos, c, g);
          const f32x4 o = (old * ao + O[z][c] * an) * inv;
          uint2 v; v.x = pack2(o[0], o[1]); v.y = pack2(o[2], o[3]);
          *(uint2*)(orow + 16 * c) = v;
        }
      }
    }
    __syncthreads();
  }
}

DI void phase_conv(const Params& p, char* smem) {
  const u16* pu = (const u16*)(p.ws + WS_PU);
  u16* mix = (u16*)(p.ws + WS_MIX);
  u16* glu = (u16*)smem;
  const int tid = threadIdx.x, lane = tid & 63, w = __builtin_amdgcn_readfirstlane(tid >> 6);
  for (int item = blockIdx.x; item < 512; item += gridDim.x) {
    const int b = item >> 5, s0 = (item & 31) * 64;
    __syncthreads();
    for (int q = tid; q < 94 * 64; q += NT) {
      const int row = q >> 6, c8 = q & 63;
      const int s = s0 - 30 + row;
      uint4 r = uint4{0u, 0u, 0u, 0u};
      if (s >= 0) {
        const u16* src = pu + (size_t)(b * SEQ + s) * 1024 + c8 * 8;
        const uint4 a = *(const uint4*)src, gt = *(const uint4*)(src + 512);
        const unsigned aw[4] = {a.x, a.y, a.z, a.w}, gw[4] = {gt.x, gt.y, gt.z, gt.w};
        unsigned ow[4];
#pragma unroll
        for (int k = 0; k < 4; ++k) {
          const float a0 = bflo(aw[k]), a1 = bfhi(aw[k]), g0 = bflo(gw[k]), g1 = bfhi(gw[k]);
          ow[k] = pack2(a0 / (1.f + __expf(-g0)), a1 / (1.f + __expf(-g1)));
        }
        r = uint4{ow[0], ow[1], ow[2], ow[3]};
      }
      *(uint4*)(glu + row * 512 + c8 * 8) = r;
    }
    __syncthreads();
    float acc[8][8];
    {
      const float4 b0 = *(const float4*)(p.conv_b + lane * 8), b1 = *(const float4*)(p.conv_b + lane * 8 + 4);
#pragma unroll
      for (int i = 0; i < 8; ++i) { acc[i][0] = b0.x; acc[i][1] = b0.y; acc[i][2] = b0.z; acc[i][3] = b0.w; acc[i][4] = b1.x; acc[i][5] = b1.y; acc[i][6] = b1.z; acc[i][7] = b1.w; }
    }
#pragma unroll 4
    for (int j = 0; j < 31; ++j) {
      const float4 w0 = *(const float4*)(p.conv_w + j * 512 + lane * 8), w1 = *(const float4*)(p.conv_w + j * 512 + lane * 8 + 4);
      const float wj[8] = {w0.x, w0.y, w0.z, w0.w, w1.x, w1.y, w1.z, w1.w};
#pragma unroll
      for (int i = 0; i < 8; ++i) {
        const uint4 v = *(const uint4*)(glu + (8 * w + i + j) * 512 + lane * 8);
        acc[i][0] += wj[0] * bflo(v.x); acc[i][1] += wj[1] * bfhi(v.x);
        acc[i][2] += wj[2] * bflo(v.y); acc[i][3] += wj[3] * bfhi(v.y);
        acc[i][4] += wj[4] * bflo(v.z); acc[i][5] += wj[5] * bfhi(v.z);
        acc[i][6] += wj[6] * bflo(v.w); acc[i][7] += wj[7] * bfhi(v.w);
      }
    }
    const float4 g0 = *(const float4*)(p.cln_g + lane * 8), g1 = *(const float4*)(p.cln_g + lane * 8 + 4);
    const float4 c0 = *(const float4*)(p.cln_b + lane * 8), c1 = *(const float4*)(p.cln_b + lane * 8 + 4);
    const float gg[8] = {g0.x, g0.y, g0.z, g0.w, g1.x, g1.y, g1.z, g1.w};
    const float cb[8] = {c0.x, c0.y, c0.z, c0.w, c1.x, c1.y, c1.z, c1.w};
#pragma unroll
    for (int i = 0; i < 8; ++i) {
      float sm = 0.f;
#pragma unroll
      for (int k = 0; k < 8; ++k) sm += acc[i][k];
      const float mean = wave_sum(sm) * (1.f / 512.f);
      float sq = 0.f;
#pragma unroll
      for (int k = 0; k < 8; ++k) { const float d = acc[i][k] - mean; sq += d * d; }
      const float rstd = rsqrtf(wave_sum(sq) * (1.f / 512.f) + LN_EPS);
      float o[8];
#pragma unroll
      for (int k = 0; k < 8; ++k) { const float y = (acc[i][k] - mean) * rstd * gg[k] + cb[k]; o[k] = y / (1.f + __expf(-y)); }
      uint4 r; r.x = pack2(o[0], o[1]); r.y = pack2(o[2], o[3]); r.z = pack2(o[4], o[5]); r.w = pack2(o[6], o[7]);
      *(uint4*)(mix + (size_t)(b * SEQ + s0 + 8 * w + i) * 1024 + lane * 8) = r;
    }
  }
}

DI void outproj_epilogue(const Params& p, const char* smem, const int m0, const int n0) {
  u16* rbuf = (u16*)(p.ws + WS_PU);
  const float* ct = (const float*)smem;
#pragma unroll 4
  for (int i = 0; i < 16; ++i) {
    const int c = threadIdx.x + NT * i, row = c >> 5, ch = c & 31;
    const float4 y = *(const float4*)(ct + row * CT_PITCH + 4 * ch);
    const size_t o = (size_t)(m0 + row) * 1024 + n0 + 4 * ch;
    const float4 xv = *(const float4*)(p.x + o), bv = *(const float4*)(p.b_out + n0 + 4 * ch);
    uint2 r; r.x = pack2(ALPHA * xv.x + y.x + bv.x, ALPHA * xv.y + y.y + bv.y); r.y = pack2(ALPHA * xv.z + y.z + bv.z, ALPHA * xv.w + y.w + bv.w);
    *(uint2*)(rbuf + o) = r;
  }
}
DI void phase_outproj(const Params& p, char* smem) {
  const u16* mix = (const u16*)(p.ws + WS_MIX);
  const u16* wt = (const u16*)(p.ws + WS_WOUT);
  const int lane = threadIdx.x & 63, g = lane >> 4, r16 = lane & 15;
  const int NTN = DM / 256;
  for (int tile = blockIdx.x, kit = 0; tile < (T / 256) * NTN; tile += gridDim.x, ++kit) {
    int mt_, nt_; tile_coords<4>(tile, kit, T / 256, NTN, mt_, nt_);
    const int m0 = mt_ * 256, n0b = nt_ * 256;
    f32x4 acc[8][4];
    gemm_tile_big(mix, wt, DM, m0, n0b, smem, acc);
    stage_acc_big<0>(acc, smem, g, r16);
    __syncthreads();
    outproj_epilogue(p, smem, m0, n0b);
    __syncthreads();
    stage_acc_big<1>(acc, smem, g, r16);
    __syncthreads();
    outproj_epilogue(p, smem, m0, n0b + 128);
    __syncthreads();
  }
}

DI void phase_ln1(const Params& p) {
  const u16* rbuf = (const u16*)(p.ws + WS_PU);
  u16* h1b = (u16*)(p.ws + WS_XB);
  unsigned char* h1f8 = p.ws + WS_H1F8;
  const int lane = threadIdx.x & 63, w = __builtin_amdgcn_readfirstlane(threadIdx.x >> 6);
  float4 gg[4], bb[4];
#pragma unroll
  for (int k = 0; k < 4; ++k) { gg[k] = *(const float4*)(p.ln1_g + 256 * k + 4 * lane); bb[k] = *(const float4*)(p.ln1_b + 256 * k + 4 * lane); }
  for (int tb = blockIdx.x; tb < T / 8; tb += 2 * gridDim.x) {
    const int tb1 = tb + (int)gridDim.x < T / 8 ? tb + (int)gridDim.x : tb;
    const int tt[2] = {tb * 8 + w, tb1 * 8 + w};
    float4 v[2][4];
#pragma unroll
    for (int z = 0; z < 2; ++z)
#pragma unroll
      for (int k = 0; k < 4; ++k) {
        const uint2 q = *(const uint2*)(rbuf + (size_t)tt[z] * 1024 + 256 * k + 4 * lane);
        v[z][k] = float4{bflo(q.x), bfhi(q.x), bflo(q.y), bfhi(q.y)};
      }
#pragma unroll
    for (int z = 0; z < 2; ++z) {
      const int t = tt[z];
      float sm = 0.f;
#pragma unroll
      for (int k = 0; k < 4; ++k) sm += v[z][k].x + v[z][k].y + v[z][k].z + v[z][k].w;
      const float mean = wave_sum(sm) * (1.f / 1024.f);
      float sq = 0.f;
#pragma unroll
      for (int k = 0; k < 4; ++k) { float d; d = v[z][k].x - mean; sq += d * d; d = v[z][k].y - mean; sq += d * d; d = v[z][k].z - mean; sq += d * d; d = v[z][k].w - mean; sq += d * d; }
      const float rstd = rsqrtf(wave_sum(sq) * (1.f / 1024.f) + LN_EPS);
      float4 o[4];
      float am = 0.f;
#pragma unroll
      for (int k = 0; k < 4; ++k) {
        const int d0 = 256 * k + 4 * lane;
        o[k].x = (v[z][k].x - mean) * rstd * gg[k].x + bb[k].x; o[k].y = (v[z][k].y - mean) * rstd * gg[k].y + bb[k].y;
        o[k].z = (v[z][k].z - mean) * rstd * gg[k].z + bb[k].z; o[k].w = (v[z][k].w - mean) * rstd * gg[k].w + bb[k].w;
        am = fmaxf(am, fmaxf(fmaxf(fabsf(o[k].x), fabsf(o[k].y)), fmaxf(fabsf(o[k].z), fabsf(o[k].w))));
        uint2 hb; hb.x = pack2(o[k].x, o[k].y); hb.y = pack2(o[k].z, o[k].w);
        *(uint2*)(h1b + (size_t)t * 1024 + d0) = hb;
      }
#pragma unroll
      for (int of = 32; of > 0; of >>= 1) am = fmaxf(am, __shfl_xor(am, of, 64));
      am = fmaxf(am, 1e-30f);
      const float q = 127.f / am;
#pragma unroll
      for (int k = 0; k < 4; ++k) *(unsigned*)(h1f8 + (size_t)t * 1024 + 256 * k + 4 * lane) = pk4_i8(o[k].x * q, o[k].y * q, o[k].z * q, o[k].w * q);
      if (lane == 0) ((float*)(p.ws + WS_SX))[t] = am * (1.f / 127.f);
    }
  }
}

DI unsigned enc_key(float s) { const unsigned u = __float_as_uint(s); return (u & 0x80000000u) ? ~u : (u | 0x80000000u); }
DI float dec_key(unsigned k) { const unsigned u = (k & 0x80000000u) ? (k & 0x7fffffffu) : ~k; return __uint_as_float(u); }
DI void cswap(unsigned& a, unsigned& b) { const unsigned hi = a > b ? a : b, lo = a > b ? b : a; a = hi; b = lo; }

DI void sort16_desc(unsigned (&v)[16]) {
  constexpr int KS[10] = {2, 4, 4, 8, 8, 8, 16, 16, 16, 16};
  constexpr int JS[10] = {1, 2, 1, 4, 2, 1, 8, 4, 2, 1};
#pragma unroll
  for (int s = 0; s < 10; ++s) {
#pragma unroll
    for (int i = 0; i < 16; ++i) {
      const int l = i ^ JS[s];
      if (l > i) {
        if ((i & KS[s]) == 0) cswap(v[i], v[l]); else cswap(v[l], v[i]);
      }
    }
  }
}
DI void merge16_desc(unsigned (&R)[16], const unsigned (&X)[16]) {
#pragma unroll
  for (int i = 0; i < 16; ++i) R[i] = R[i] > X[15 - i] ? R[i] : X[15 - i];
  constexpr int JS[4] = {8, 4, 2, 1};
#pragma unroll
  for (int s = 0; s < 4; ++s) {
#pragma unroll
    for (int i = 0; i < 16; ++i) {
      const int l = i ^ JS[s];
      if (l > i) cswap(R[i], R[l]);
    }
  }
}

struct CandTab { int i[64]; int j[64]; int n; };
constexpr CandTab make_cands() {
  CandTab t{};
  int n = 0;
  for (int i = 0; i < 16; ++i)
    for (int j = 0; j < 16; ++j)
      if ((i + 1) * (j + 1) <= 16) { t.i[n] = i; t.j[n] = j; ++n; }
  t.n = n;
  for (int k = n; k < 64; ++k) { t.i[k] = 0; t.j[k] = 0; }
  return t;
}

DI void phase_peer_q(const Params& p, char* smem) {
  const u16* h1b = (const u16*)(p.ws + WS_XB);
  const u16* wt = (const u16*)(p.ws + WS_WQ);
  const u16* keysb = (const u16*)(p.ws + WS_KEYS);
  int* sel_i = (int*)(p.ws + WS_SELI);
  float* sel_g = (float*)(p.ws + WS_SELG);
  float* Sbuf = (float*)smem;
  unsigned* xch = (unsigned*)(smem + 128 * 257 * 4);
  const int tid = threadIdx.x, lane = tid & 63, w = __builtin_amdgcn_readfirstlane(tid >> 6), g = lane >> 4, r16 = lane & 15;
  constexpr int WM = 2;
  const int wm = w % WM, wn = w / WM;
  for (int tile = blockIdx.x, kit = 0; tile < (T / 128) * 8; tile += gridDim.x, ++kit) {
    int mt_, nt_; tile_coords<8>(tile, kit, T / 128, 8, mt_, nt_);
    const int m0 = mt_ * 128, hd = nt_, n0 = hd * 256;
    {
      f32x4 acc[4][4];
      gemm_tile<WM>(h1b, wt, DM, m0, n0, smem, acc);
#pragma unroll
      for (int mi = 0; mi < 4; ++mi)
#pragma unroll
        for (int ni = 0; ni < 4; ++ni)
#pragma unroll
          for (int j = 0; j < 4; ++j) {
            const int row = 64 * wm + 16 * mi + 4 * g + j, col = 64 * wn + 16 * ni + r16;
            *(u16*)(smem + row * 512 + (((col >> 3) ^ (row & 15)) << 4) + (col & 7) * 2) = f2bf(acc[mi][ni][j]);
          }
    }
    __syncthreads();
    f32x4 sc[2][2][4];
    {
      const int swm = w & 3, swn = w >> 2;
#pragma unroll
      for (int pp = 0; pp < 2; ++pp) {
#pragma unroll
        for (int mi = 0; mi < 2; ++mi)
#pragma unroll
          for (int ni = 0; ni < 4; ++ni) sc[pp][mi][ni] = f32x4{0.f, 0.f, 0.f, 0.f};
        bf16x8 bfr[4][4];
#pragma unroll
        for (int kk = 0; kk < 4; ++kk)
#pragma unroll
          for (int ni = 0; ni < 4; ++ni) {
            const int n = 64 * swn + 16 * ni + r16;
            bfr[kk][ni] = *(const bf16x8*)(keysb + ((size_t)(((hd * 2 + pp) * 4 + kk) * 4 + g) * 128 + n) * 8);
          }
#pragma unroll
        for (int kk = 0; kk < 4; ++kk) {
          bf16x8 af[2];
#pragma unroll
          for (int mi = 0; mi < 2; ++mi) {
            const int row = 32 * swm + 16 * mi + r16, c = 16 * pp + 4 * kk + g;
            af[mi] = *(const bf16x8*)(smem + row * 512 + ((c ^ (row & 15)) << 4));
          }
#pragma unroll
          for (int mi = 0; mi < 2; ++mi)
#pragma unroll
            for (int ni = 0; ni < 4; ++ni) sc[pp][mi][ni] = MFMA16(af[mi], bfr[kk][ni], sc[pp][mi][ni]);
        }
      }
      __syncthreads();
#pragma unroll
      for (int pp = 0; pp < 2; ++pp)
#pragma unroll
        for (int mi = 0; mi < 2; ++mi)
#pragma unroll
          for (int ni = 0; ni < 4; ++ni)
#pragma unroll
            for (int j = 0; j < 4; ++j) {
              const int row = 32 * swm + 16 * mi + 4 * g + j, n = 64 * swn + 16 * ni + r16;
              Sbuf[row * 257 + pp * 128 + n] = sc[pp][mi][ni][j];
            }
    }
    __syncthreads();
    unsigned R[16];
    const int tok = tid & 127, half = (tid >> 7) & 1;
    if (tid < 256) {
      const float* srow = Sbuf + tok * 257 + half * 128;
#pragma unroll
      for (int i = 0; i < 16; ++i) R[i] = (enc_key(srow[i]) & ~127u) | (unsigned)(127 - i);
      sort16_desc(R);
#pragma unroll 1
      for (int gi = 1; gi < 8; ++gi) {
        unsigned X[16];
#pragma unroll
        for (int i = 0; i < 16; ++i) X[i] = (enc_key(srow[gi * 16 + i]) & ~127u) | (unsigned)(127 - (gi * 16 + i));
        sort16_desc(X);
        merge16_desc(R, X);
      }
#pragma unroll
      for (int i = 0; i < 16; ++i) xch[(tok * 2 + half) * 16 + i] = R[i];
    }
    __syncthreads();
    if (tid < 128) {
      constexpr CandTab CT = make_cands();
      float s1[16], s2[16];
#pragma unroll
      for (int i = 0; i < 16; ++i) { s1[i] = dec_key(R[i] & ~127u); s2[i] = dec_key(xch[(tok * 2 + 1) * 16 + i] & ~127u); }
      unsigned B[16];
#pragma unroll
      for (int gi = 0; gi < 4; ++gi) {
        unsigned X[16];
#pragma unroll
        for (int i = 0; i < 16; ++i) {
          const int c = gi * 16 + i;
          X[i] = (c < CT.n) ? ((enc_key(s1[CT.i[c]] + s2[CT.j[c]]) & ~255u) | (unsigned)(255 - (CT.i[c] * 16 + CT.j[c]))) : 0u;
        }
        sort16_desc(X);
        if (gi == 0) {
#pragma unroll
          for (int i = 0; i < 16; ++i) B[i] = X[i];
        } else merge16_desc(B, X);
      }
      float e[16], sum = 0.f;
      const float s0 = dec_key(B[0] & ~255u);
#pragma unroll
      for (int i = 0; i < 16; ++i) { e[i] = __expf(dec_key(B[i] & ~255u) - s0); sum += e[i]; }
      const float inv = 1.f / sum;
      int ids[16];
#pragma unroll
      for (int i = 0; i < 16; ++i) {
        const int flat = 255 - (int)(B[i] & 255u);
        const int i1 = 127 - (int)(xch[(tok * 2 + 0) * 16 + (flat >> 4)] & 127u);
        const int i2 = 127 - (int)(xch[(tok * 2 + 1) * 16 + (flat & 15)] & 127u);
        ids[i] = i1 * 128 + i2;
        e[i] *= inv;
      }
      int* di = sel_i + (size_t)(m0 + tok) * 128 + hd * 16;
      float* dg = sel_g + (size_t)(m0 + tok) * 128 + hd * 16;
#pragma unroll
      for (int k = 0; k < 4; ++k) {
        *(int4*)(di + 4 * k) = int4{ids[4 * k], ids[4 * k + 1], ids[4 * k + 2], ids[4 * k + 3]};
        *(float4*)(dg + 4 * k) = float4{e[4 * k], e[4 * k + 1], e[4 * k + 2], e[4 * k + 3]};
      }
    }
    __syncthreads();
  }
}

DI unsigned xcc_id() { return (unsigned)__builtin_amdgcn_s_getreg((3 << 11) | 20) & 0xFu; }
DI unsigned ld_agent(const unsigned* q) { return __hip_atomic_load(q, __ATOMIC_RELAXED, __HIP_MEMORY_SCOPE_AGENT); }

DI void fp8x16_to_f32(const uint4& q, f32x2 (&x)[8]) {
  const unsigned w[4] = {q.x, q.y, q.z, q.w};
#pragma unroll
  for (int k = 0; k < 4; ++k) { x[2 * k] = __builtin_amdgcn_cvt_pk_f32_fp8((int)w[k], false); x[2 * k + 1] = __builtin_amdgcn_cvt_pk_f32_fp8((int)w[k], true); }
}
struct SliceOwner { unsigned mine; int nblk; };
DI SliceOwner read_census(const Params& p, const unsigned my_xcc) {
  const unsigned* census = (const unsigned*)(p.ws + WS_BAR) + 64;
  unsigned cnt[8]; unsigned fallback = 8;
#pragma unroll
  for (int x = 7; x >= 0; --x) { cnt[x] = ld_agent(census + 64 * x); if (cnt[x] > 0) fallback = x; }
  SliceOwner o; o.mine = 0u; o.nblk = 1;
#pragma unroll
  for (int x = 0; x < 8; ++x) {
    const unsigned owner = cnt[x] > 0 ? (unsigned)x : fallback;
    if (owner == my_xcc) o.mine |= 1u << x;
    if ((unsigned)x == my_xcc) o.nblk = (int)cnt[x];
  }
  return o;
}

DI void eu_load(const unsigned char* __restrict__ ub8, const int id0, const int id1, const int cs, const int lane, uint4 (&u)[16]) {
#pragma unroll
  for (int i = 0; i < 16; ++i) {
    const int id = __shfl(i < 8 ? id0 : id1, (8 * i + (lane >> 3)) & 63, 64);
    u[i] = *(const uint4*)(ub8 + (size_t)id * 1024 + 128 * cs + 16 * (lane & 7));
  }
}
DI void eu_compute(const uint4 (&u)[16], const uint4& xq, int* __restrict__ pd, const int lane) {
  int p[16];
#pragma unroll
  for (int i = 0; i < 16; ++i) {
    int acc = __builtin_amdgcn_sdot4((int)u[i].x, (int)xq.x, 0, false);
    acc = __builtin_amdgcn_sdot4((int)u[i].y, (int)xq.y, acc, false);
    acc = __builtin_amdgcn_sdot4((int)u[i].z, (int)xq.z, acc, false);
    p[i] = __builtin_amdgcn_sdot4((int)u[i].w, (int)xq.w, acc, false);
  }
  int q8[8], q4[4], q2[2];
  const bool b2 = lane & 4, b1 = lane & 2, b0 = lane & 1;
#pragma unroll
  for (int j = 0; j < 8; ++j) { const int keep = b2 ? p[8 + j] : p[j], send = b2 ? p[j] : p[8 + j]; q8[j] = keep + __shfl_xor(send, 4, 64); }
#pragma unroll
  for (int j = 0; j < 4; ++j) { const int keep = b1 ? q8[4 + j] : q8[j], send = b1 ? q8[j] : q8[4 + j]; q4[j] = keep + __shfl_xor(send, 2, 64); }
#pragma unroll
  for (int j = 0; j < 2; ++j) { const int keep = b0 ? q4[2 + j] : q4[j], send = b0 ? q4[j] : q4[2 + j]; q2[j] = keep + __shfl_xor(send, 1, 64); }
  const int slot0 = 16 * (lane & 7) + (lane >> 3);
  pd[slot0] = q2[0];
  pd[slot0 + 8] = q2[1];
}
DI void phase_eu(const Params& p, const unsigned my_xcc, const unsigned my_rank) {
  const unsigned char* h1f8 = p.ws + WS_H1F8;
  const unsigned char* ub8 = p.ws + WS_UB;
  const int* sel_i = (const int*)(p.ws + WS_SELI);
  int* pdot = (int*)(p.ws + WS_PDOT);
  const int lane = threadIdx.x & 63, w = __builtin_amdgcn_readfirstlane(threadIdx.x >> 6);
  const SliceOwner so = read_census(p, my_xcc);
#pragma unroll 1
  for (int cs = 0; cs < 8; ++cs) {
    if (!((so.mine >> cs) & 1u)) continue;
    const int nblk = so.nblk;
    int* pd = pdot + (size_t)cs * T * 128;
    if ((int)my_rank >= T / 8) continue;
    const int K = (T / 8 - (int)my_rank + nblk - 1) / nblk;
#define TOK(k) (((int)my_rank + ((k) < K ? (k) : K - 1) * nblk) * 8 + w)
#define EU_IDS(t, i0, i1, xq) do { i0 = sel_i[(size_t)(t) * 128 + lane]; i1 = sel_i[(size_t)(t) * 128 + 64 + lane]; \
                                   xq = *(const uint4*)(h1f8 + (size_t)(t) * 1024 + 128 * cs + 16 * (lane & 7)); } while (0)
    int tA = TOK(0), tB = TOK(1);
    int a0, a1, b0, b1; uint4 xa, xb;
    EU_IDS(tA, a0, a1, xa);
    EU_IDS(tB, b0, b1, xb);
    uint4 uA[16], uB[16];
    eu_load(ub8, a0, a1, cs, lane, uA);
    for (int k = 0; k < K; k += 2) {
      eu_load(ub8, b0, b1, cs, lane, uB);
      const int tA2 = TOK(k + 2); int na0, na1; uint4 nxa;
      EU_IDS(tA2, na0, na1, nxa);
      eu_compute(uA, xa, pd + (size_t)tA * 128, lane);
      eu_load(ub8, na0, na1, cs, lane, uA);
      const int tB2 = TOK(k + 3); int nb0, nb1; uint4 nxb;
      EU_IDS(tB2, nb0, nb1, nxb);
      eu_compute(uB, xb, pd + (size_t)tB * 128, lane);
      tA = tA2; a0 = na0; a1 = na1; xa = nxa; tB = tB2; b0 = nb0; b1 = nb1; xb = nxb;
    }
#undef EU_IDS
  }
}

DI void phase_ec(const Params& p) {
  const int* pdot = (const int*)(p.ws + WS_PDOT);
  const float* sel_g = (const float*)(p.ws + WS_SELG);
  const int* sel_i = (const int*)(p.ws + WS_SELI);
  const float* su = (const float*)(p.ws + WS_SU);
  const float* sx = (const float*)(p.ws + WS_SX);
  float* cbuf = (float*)(p.ws + WS_CBUF);
  const size_t gsz = (size_t)gridDim.x * NT, n = (size_t)T * 128;
  size_t i = (size_t)blockIdx.x * NT + threadIdx.x;
  for (; i + gsz < n; i += 2 * gsz) {
    int d[2] = {0, 0}; int id[2]; float g[2], s2[2];
#pragma unroll
    for (int z = 0; z < 2; ++z) {
      const size_t e = i + z * gsz;
#pragma unroll
      for (int cs = 0; cs < 8; ++cs) d[z] += pdot[(size_t)cs * T * 128 + e];
      id[z] = sel_i[e]; g[z] = sel_g[e]; s2[z] = sx[e >> 7];
    }
#pragma unroll
    for (int z = 0; z < 2; ++z) {
      const float xx = (float)d[z] * su[id[z]] * s2[z];
      const float act = 0.5f * xx * (1.f + erff(xx * 0.70710678118654752f));
      cbuf[i + z * gsz] = act * g[z] * (1.f / V_SCALE);
    }
  }
  for (; i < n; i += gsz) {
    int d = 0;
#pragma unroll
    for (int cs = 0; cs < 8; ++cs) d += pdot[(size_t)cs * T * 128 + i];
    const float xx = (float)d * su[sel_i[i]] * sx[i >> 7];
    const float act = 0.5f * xx * (1.f + erff(xx * 0.70710678118654752f));
    cbuf[i] = act * sel_g[i] * (1.f / V_SCALE);
  }
}

DI void ev_load(const unsigned char* __restrict__ vb8, const int id0, const int id1, const int cs, const int lane, uint4 (&v)[16]) {
#pragma unroll
  for (int i = 0; i < 16; ++i) {
    const int id = __shfl(i < 8 ? id0 : id1, (8 * i + (lane >> 3)) & 63, 64);
    v[i] = *(const uint4*)(vb8 + (size_t)id * 1024 + 128 * cs + 16 * (lane & 7));
  }
}
DI void ev_compute(const uint4 (&v)[16], const float c0, const float c1, u16* __restrict__ yrow, const int lane) {
  f32x2 acc[8];
#pragma unroll
  for (int k = 0; k < 8; ++k) acc[k] = f32x2{0.f, 0.f};
#pragma unroll
  for (int i = 0; i < 16; ++i) {
    const float c = __shfl(i < 8 ? c0 : c1, (8 * i + (lane >> 3)) & 63, 64);
    const f32x2 cc = f32x2{c, c};
    f32x2 vf[8];
    fp8x16_to_f32(v[i], vf);
#pragma unroll
    for (int k = 0; k < 8; ++k) acc[k] = __builtin_elementwise_fma(vf[k], cc, acc[k]);
  }
  float a[16];
#pragma unroll
  for (int k = 0; k < 8; ++k) { a[2 * k] = acc[k][0]; a[2 * k + 1] = acc[k][1]; }
  float q8[8], q4[4], q2[2];
  const bool b5 = lane & 32, b4 = lane & 16, b3 = lane & 8;
#pragma unroll
  for (int j = 0; j < 8; ++j) { const float keep = b5 ? a[8 + j] : a[j], send = b5 ? a[j] : a[8 + j]; q8[j] = keep + __shfl_xor(send, 32, 64); }
#pragma unroll
  for (int j = 0; j < 4; ++j) { const float keep = b4 ? q8[4 + j] : q8[j], send = b4 ? q8[j] : q8[4 + j]; q4[j] = keep + __shfl_xor(send, 16, 64); }
#pragma unroll
  for (int j = 0; j < 2; ++j) { const float keep = b3 ? q4[2 + j] : q4[j], send = b3 ? q4[j] : q4[2 + j]; q2[j] = keep + __shfl_xor(send, 8, 64); }
  *(unsigned*)(yrow + 16 * (lane & 7) + 2 * (lane >> 3)) = pack2(q2[0], q2[1]);
}

DI void phase_ev(const Params& p, const unsigned my_xcc, const unsigned my_rank) {
  const unsigned char* vb8 = p.ws + WS_VB;
  const int* sel_i = (const int*)(p.ws + WS_SELI);
  const float* cbuf = (const float*)(p.ws + WS_CBUF);
  u16* ybuf = (u16*)(p.ws + WS_YBUF);
  const int lane = threadIdx.x & 63, w = __builtin_amdgcn_readfirstlane(threadIdx.x >> 6);
  const SliceOwner so = read_census(p, my_xcc);
#pragma unroll 1
  for (int cs = 0; cs < 8; ++cs) {
    if (!((so.mine >> cs) & 1u)) continue;
    const int nblk = so.nblk;
    if ((int)my_rank >= T / 8) continue;
    const int K = (T / 8 - (int)my_rank + nblk - 1) / nblk;
#define EV_IDS(t, i0, i1, c0, c1) do { i0 = sel_i[(size_t)(t) * 128 + lane]; i1 = sel_i[(size_t)(t) * 128 + 64 + lane]; \
                                       c0 = cbuf[(size_t)(t) * 128 + lane]; c1 = cbuf[(size_t)(t) * 128 + 64 + lane]; } while (0)
    int tA = TOK(0), tB = TOK(1);
    int a0, a1, b0, b1; float ca0, ca1, cb0, cb1;
    EV_IDS(tA, a0, a1, ca0, ca1);
    EV_IDS(tB, b0, b1, cb0, cb1);
    uint4 vA[16], vB[16];
    ev_load(vb8, a0, a1, cs, lane, vA);
    for (int k = 0; k < K; k += 2) {
      ev_load(vb8, b0, b1, cs, lane, vB);
      const int tA2 = TOK(k + 2); int na0, na1; float nca0, nca1;
      EV_IDS(tA2, na0, na1, nca0, nca1);
      ev_compute(vA, ca0, ca1, ybuf + (size_t)tA * 1024 + 128 * cs, lane);
      ev_load(vb8, na0, na1, cs, lane, vA);
      const int tB2 = TOK(k + 3); int nb0, nb1; float ncb0, ncb1;
      EV_IDS(tB2, nb0, nb1, ncb0, ncb1);
      ev_compute(vB, cb0, cb1, ybuf + (size_t)tB * 1024 + 128 * cs, lane);
      tA = tA2; a0 = na0; a1 = na1; ca0 = nca0; ca1 = nca1; tB = tB2; b0 = nb0; b1 = nb1; cb0 = ncb0; cb1 = ncb1;
    }
#undef EV_IDS
#undef TOK
  }
}

DI void phase_ln2(const Params& p) {
  const u16* ybuf = (const u16*)(p.ws + WS_YBUF);
  const u16* h1b = (const u16*)(p.ws + WS_XB);
  const int lane = threadIdx.x & 63, w = __builtin_amdgcn_readfirstlane(threadIdx.x >> 6);
  float4 gg[4], bb[4];
#pragma unroll
  for (int k = 0; k < 4; ++k) { gg[k] = *(const float4*)(p.ln2_g + 256 * k + 4 * lane); bb[k] = *(const float4*)(p.ln2_b + 256 * k + 4 * lane); }
  for (int tb = blockIdx.x; tb < T / 8; tb += 2 * gridDim.x) {
    const int tb1 = tb + (int)gridDim.x < T / 8 ? tb + (int)gridDim.x : tb;
    const int tt[2] = {tb * 8 + w, tb1 * 8 + w};
    float4 v[2][4];
#pragma unroll
    for (int z = 0; z < 2; ++z)
#pragma unroll
      for (int k = 0; k < 4; ++k) {
        const uint2 hq = *(const uint2*)(h1b + (size_t)tt[z] * 1024 + 256 * k + 4 * lane);
        const uint2 yq = *(const uint2*)(ybuf + (size_t)tt[z] * 1024 + 256 * k + 4 * lane);
        const float4 y = float4{bflo(yq.x), bfhi(yq.x), bflo(yq.y), bfhi(yq.y)};
        v[z][k] = float4{ALPHA * bflo(hq.x) + y.x, ALPHA * bfhi(hq.x) + y.y, ALPHA * bflo(hq.y) + y.z, ALPHA * bfhi(hq.y) + y.w};
      }
#pragma unroll
    for (int z = 0; z < 2; ++z) {
      float sm = 0.f;
#pragma unroll
      for (int k = 0; k < 4; ++k) sm += v[z][k].x + v[z][k].y + v[z][k].z + v[z][k].w;
      const float mean = wave_sum(sm) * (1.f / 1024.f);
      float sq = 0.f;
#pragma unroll
      for (int k = 0; k < 4; ++k) { float d; d = v[z][k].x - mean; sq += d * d; d = v[z][k].y - mean; sq += d * d; d = v[z][k].z - mean; sq += d * d; d = v[z][k].w - mean; sq += d * d; }
      const float rstd = rsqrtf(wave_sum(sq) * (1.f / 1024.f) + LN_EPS);
#pragma unroll
      for (int k = 0; k < 4; ++k) {
        float4 o;
        o.x = (v[z][k].x - mean) * rstd * gg[k].x + bb[k].x; o.y = (v[z][k].y - mean) * rstd * gg[k].y + bb[k].y;
        o.z = (v[z][k].z - mean) * rstd * gg[k].z + bb[k].z; o.w = (v[z][k].w - mean) * rstd * gg[k].w + bb[k].w;
        *(float4*)(p.out + (size_t)tt[z] * 1024 + 256 * k + 4 * lane) = o;
      }
    }
  }
}

DI void grid_barrier(unsigned* ctr, unsigned target) {
  asm volatile("s_waitcnt vmcnt(0)" ::: "memory");
  __syncthreads();
  if (threadIdx.x == 0) {
    __builtin_amdgcn_fence(__ATOMIC_RELEASE, "agent");
    asm volatile("s_waitcnt vmcnt(0)" ::: "memory");
    (void)__hip_atomic_fetch_add(ctr, 1u, __ATOMIC_RELAXED, __HIP_MEMORY_SCOPE_AGENT);
    unsigned spins = 0;
    while (__hip_atomic_load(ctr, __ATOMIC_RELAXED, __HIP_MEMORY_SCOPE_AGENT) < target) {
      __builtin_amdgcn_s_sleep(1);
      if (++spins > (1u << 24)) break;
    }
    __builtin_amdgcn_fence(__ATOMIC_ACQUIRE, "agent");
    asm volatile("s_waitcnt vmcnt(0)" ::: "memory");
  }
  __syncthreads();
}

DI void grid_barrier_xcd(unsigned* bar, const unsigned gen, const unsigned my_xcc, const unsigned n_local, const unsigned n_xcds) {
  asm volatile("s_waitcnt vmcnt(0)" ::: "memory");
  __syncthreads();
  if (threadIdx.x == 0) {
    unsigned* xcnt = bar + 768 + 32 * my_xcc;
    unsigned* top = bar + 640;
    unsigned* rel = bar + 704;
    const unsigned old = __hip_atomic_fetch_add(xcnt, 1u, __ATOMIC_RELAXED, __HIP_MEMORY_SCOPE_AGENT);
    if (old + 1u == gen * n_local) {
      __builtin_amdgcn_fence(__ATOMIC_RELEASE, "agent");
      asm volatile("s_waitcnt vmcnt(0)" ::: "memory");
      const unsigned t = __hip_atomic_fetch_add(top, 1u, __ATOMIC_RELAXED, __HIP_MEMORY_SCOPE_AGENT);
      if (t + 1u == gen * n_xcds) __hip_atomic_store(rel, gen, __ATOMIC_RELAXED, __HIP_MEMORY_SCOPE_AGENT);
    }
    unsigned spins = 0;
    while (__hip_atomic_load(rel, __ATOMIC_RELAXED, __HIP_MEMORY_SCOPE_AGENT) < gen) {
      __builtin_amdgcn_s_sleep(1);
      if (++spins > (1u << 24)) break;
    }
    __builtin_amdgcn_fence(__ATOMIC_ACQUIRE, "agent");
    asm volatile("s_waitcnt vmcnt(0)" ::: "memory");
  }
  __syncthreads();
}

__global__ void __launch_bounds__(NT) hymba_fwd(Params p) {
  extern __shared__ __attribute__((aligned(16))) char smem[];
  const int lo = p.ph_lo, hi = p.ph_hi;
  const unsigned my_xcc = xcc_id() & 7u;
  unsigned my_rank = 0;
  if (threadIdx.x == 0) {
    my_rank = __hip_atomic_fetch_add((unsigned*)(p.ws + WS_BAR) + 64 + 64 * my_xcc, 1u, __ATOMIC_RELAXED, __HIP_MEMORY_SCOPE_AGENT);
    (void)__hip_atomic_fetch_add((unsigned*)(p.ws + WS_BAR) + 576, 1u, __ATOMIC_RELAXED, __HIP_MEMORY_SCOPE_AGENT);
  }
  if (threadIdx.x == 0) *(unsigned*)smem = my_rank;
  __syncthreads();
  my_rank = *(const unsigned*)smem;
  __syncthreads();
#define IN(k) (lo <= (k) && (k) < hi)
  unsigned bar_target = 0;
  unsigned xgen = 0, n_local = 0, n_xcds = 0;
#define SEAM(k) do { if (IN(k) && IN((k) + 1)) { \
    if (n_local == 0) { \
      if (threadIdx.x == 0) { unsigned sp_ = 0; while (ld_agent((const unsigned*)(p.ws + WS_BAR) + 576) < gridDim.x) { __builtin_amdgcn_s_sleep(1); if (++sp_ > (1u << 24)) break; } } \
      __syncthreads(); \
      _Pragma("unroll") for (int x_ = 0; x_ < 8; ++x_) { const unsigned c_ = ld_agent((const unsigned*)(p.ws + WS_BAR) + 64 + 64 * x_); n_xcds += c_ > 0; if ((unsigned)x_ == my_xcc) n_local = c_; } \
    } \
    ++xgen; grid_barrier_xcd((unsigned*)(p.ws + WS_BAR), xgen, my_xcc, n_local, n_xcds); } } while (0)
  if (IN(0)) {
    const size_t gtid = (size_t)blockIdx.x * NT + threadIdx.x, gsz = (size_t)gridDim.x * NT;
    cvt_linear(p.x, (u16*)(p.ws + WS_XB), (size_t)T * DM / 8, gtid, gsz);
    {
      u16* kd = (u16*)(p.ws + WS_KEYS);
      for (size_t i = gtid; i < (size_t)8 * 2 * 128 * 16; i += gsz) {
        const int c8 = (int)(i & 15), n = (int)((i >> 4) & 127), hp = (int)(i >> 11);
        const float4 a = *(const float4*)(p.keys + i * 8), b = *(const float4*)(p.keys + i * 8 + 4);
        *(uint4*)(kd + ((size_t)((hp * 4 + (c8 >> 2)) * 4 + (c8 & 3)) * 128 + n) * 8) = cvt8(a, b);
      }
    }
    cvt_transpose(p.w_in, (u16*)(p.ws + WS_WIN), DM, NPROJ, gtid, gsz);
  }
  SEAM(0);
  if (IN(1)) phase_inproj(p, smem);
  SEAM(1);
  if (IN(2)) { phase_attn(p, smem); phase_conv(p, smem); }
  SEAM(2);
  if (IN(3)) phase_outproj(p, smem);
  SEAM(3);
  if (IN(4)) phase_ln1(p);
  SEAM(4);
  if (IN(5)) phase_peer_q(p, smem);
  SEAM(5);
  if (IN(6)) phase_eu(p, my_xcc, my_rank);
  SEAM(6);
  if (IN(7)) phase_ec(p);
  SEAM(7);
  if (IN(8)) phase_ev(p, my_xcc, my_rank);
  SEAM(8);
  if (IN(9)) phase_ln2(p);
#undef IN
#undef SEAM
}

extern "C" void kernel_launch(void* const* d_in, const int* in_sizes, int n_in, void* d_out, int out_size, void* d_ws, size_t ws_size, hipStream_t stream) {
  static int grid = 0;
  if (grid == 0) {
    int dev = 0, cus = 0, per_cu = 0;
    hipGetDevice(&dev);
    hipDeviceGetAttribute(&cus, hipDeviceAttributeMultiprocessorCount, dev);
    hipFuncSetAttribute((const void*)hymba_fwd, hipFuncAttributeMaxDynamicSharedMemorySize, LDS_BYTES);
    if (hipOccupancyMaxActiveBlocksPerMultiprocessor(&per_cu, (const void*)hymba_fwd, NT, LDS_BYTES) != hipSuccess || per_cu < 1) {
      fprintf(stderr, "kernel_launch: occupancy query gave %d blocks per CU\n", per_cu); per_cu = 1;
    }
    (void)hipGetLastError();
    if (per_cu > 1) per_cu = 1;
    grid = cus * per_cu;
    if (ws_size < WS_END) fprintf(stderr, "kernel_launch: workspace too small: %zu < %zu\n", ws_size, (size_t)WS_END);
  }
  Params p{};
  p.x = (const float*)d_in[0]; p.w_in = (const float*)d_in[1]; p.b_in = (const float*)d_in[2]; p.conv_w = (const float*)d_in[3];
  p.conv_b = (const float*)d_in[4]; p.cln_g = (const float*)d_in[5]; p.cln_b = (const float*)d_in[6]; p.w_out = (const float*)d_in[7];
  p.b_out = (const float*)d_in[8]; p.ln1_g = (const float*)d_in[9]; p.ln1_b = (const float*)d_in[10]; p.wq = (const float*)d_in[11];
  p.keys = (const float*)d_in[12]; p.ut = (const float*)d_in[13]; p.vt = (const float*)d_in[14]; p.ln2_g = (const float*)d_in[15];
  p.ln2_b = (const float*)d_in[16];
  p.out = (float*)d_out; p.ws = (unsigned char*)d_ws;
  p.ph_lo = 0; p.ph_hi = 10;
  (void)hipMemsetAsync((unsigned char*)d_ws + WS_BAR, 0, 4096, stream);
  hipLaunchKernelGGL(hymba_fwd, dim3(grid), dim3(NT), LDS_BYTES, stream, p);
}
```

```cpp
#include <hip/hip_runtime.h>
#include <cstdio>

typedef __attribute__((ext_vector_type(8))) short bf16x8;
typedef __attribute__((ext_vector_type(4))) float f32x4;
typedef unsigned short u16;
#define DI __device__ __forceinline__
#define MFMA16(a, b, c) __builtin_amdgcn_mfma_f32_16x16x32_bf16((a), (b), (c), 0, 0, 0)


constexpr int NT = 512;
constexpr int T = 32768;
constexpr int SEQ = 2048;
constexpr int DM = 1024;
constexpr int NPROJ = 2560;
constexpr float ALPHA = 1.189207115002721f;
constexpr float LN_EPS = 1e-5f;
constexpr float LOG2E = 1.4426950408889634f;
constexpr float V_SCALE = 8.f;

constexpr size_t MB = 1024 * 1024;
constexpr size_t WS_XB = 0;
constexpr size_t WS_WIN = WS_XB + 64 * MB;
constexpr size_t WS_WOUT = WS_WIN + 5 * MB;
constexpr size_t WS_WQ = WS_WOUT + 2 * MB;
constexpr size_t WS_KEYS = WS_WQ + 4 * MB;
constexpr size_t WS_UB = WS_KEYS + 1 * MB;
constexpr size_t WS_VB = WS_UB + 32 * MB;
constexpr size_t WS_PU = WS_VB + 32 * MB;
constexpr size_t WS_Q = WS_PU + 64 * MB;
constexpr size_t WS_K = WS_Q + 32 * MB;
constexpr size_t WS_VT = WS_K + 32 * MB;
constexpr size_t WS_VT4 = WS_VT + 32 * MB;
constexpr size_t WS_VT16 = WS_VT4 + 32 * MB;
constexpr size_t WS_K4 = WS_VT16 + 32 * MB;
constexpr size_t WS_MIX = WS_K4 + 32 * MB;
constexpr size_t WS_H1F8 = WS_MIX;
constexpr size_t WS_CBUF = WS_MIX + 32 * MB;
constexpr size_t WS_PDOT = WS_PU;
constexpr size_t WS_YBUF = WS_PU;
constexpr size_t WS_SELI = WS_MIX + 64 * MB;
constexpr size_t WS_SELG = WS_SELI + 16 * MB;
constexpr size_t WS_K16 = WS_SELI;
constexpr size_t WS_BAR = WS_SELG + 16 * MB;
constexpr size_t WS_SU = WS_BAR + 4096;
constexpr size_t WS_SX = WS_SU + 65536;
constexpr size_t WS_END = WS_SX + 131072;

constexpr int LDS_BYTES = 128 * 257 * 4 + 128 * 2 * 16 * 4;

struct Params {
  const float* x; const float* w_in; const float* b_in; const float* conv_w; const float* conv_b; const float* cln_g; const float* cln_b;
  const float* w_out; const float* b_out; const float* ln1_g; const float* ln1_b; const float* wq; const float* keys; const float* ut; const float* vt;
  const float* ln2_g; const float* ln2_b;
  float* out; unsigned char* ws;
  int ph_lo, ph_hi;
};

typedef float f32x2 __attribute__((ext_vector_type(2)));
typedef __bf16 bf16x2_t __attribute__((ext_vector_type(2)));
DI unsigned pack2(float a, float b) { const f32x2 v = {a, b}; const bf16x2_t r = __builtin_convertvector(v, bf16x2_t); return __builtin_bit_cast(unsigned, r); }
DI u16 f2bf(float x) { return (u16)(pack2(x, x) & 0xffffu); }
DI float bf2f(u16 h) { return __uint_as_float(((unsigned)h) << 16); }
DI float bflo(unsigned w) { return __uint_as_float(w << 16); }
DI float bfhi(unsigned w) { return __uint_as_float(w & 0xffff0000u); }
DI float wave_sum(float v) {
#pragma unroll
  for (int o = 32; o > 0; o >>= 1) v += __shfl_xor(v, o, 64);
  return v;
}
DI uint4 cvt8(const float4 a, const float4 b) { uint4 r; r.x = pack2(a.x, a.y); r.y = pack2(a.z, a.w); r.z = pack2(b.x, b.y); r.w = pack2(b.z, b.w); return r; }

DI void cvt_linear(const float* __restrict__ src, u16* __restrict__ dst, size_t n8, size_t gtid, size_t gsz) {
  for (size_t i = gtid; i < n8; i += gsz) {
    const float4 a = *(const float4*)(src + i * 8), b = *(const float4*)(src + i * 8 + 4);
    *(uint4*)(dst + i * 8) = cvt8(a, b);
  }
}
DI unsigned pk4_fp8(float a, float b, float c, float d) {
  int r = 0;
  r = __builtin_amdgcn_cvt_pk_fp8_f32(a, b, r, false);
  r = __builtin_amdgcn_cvt_pk_fp8_f32(c, d, r, true);
  return (unsigned)r;
}
DI void cvt_linear_fp8(const float* __restrict__ src, unsigned char* __restrict__ dst, size_t n16, float scale, size_t gtid, size_t gsz) {
  for (size_t i = gtid; i < n16; i += gsz) {
    const float4 a = *(const float4*)(src + i * 16), b = *(const float4*)(src + i * 16 + 4), c = *(const float4*)(src + i * 16 + 8), d = *(const float4*)(src + i * 16 + 12);
    uint4 r;
    r.x = pk4_fp8(a.x * scale, a.y * scale, a.z * scale, a.w * scale); r.y = pk4_fp8(b.x * scale, b.y * scale, b.z * scale, b.w * scale);
    r.z = pk4_fp8(c.x * scale, c.y * scale, c.z * scale, c.w * scale); r.w = pk4_fp8(d.x * scale, d.y * scale, d.z * scale, d.w * scale);
    *(uint4*)(dst + i * 16) = r;
  }
}
DI unsigned pk4_i8(float a, float b, float c, float d) {
  const int ia = (int)rintf(a), ib = (int)rintf(b), ic = (int)rintf(c), id = (int)rintf(d);
  return (unsigned)(ia & 255) | ((unsigned)(ib & 255) << 8) | ((unsigned)(ic & 255) << 16) | ((unsigned)(id & 255) << 24);
}
DI void cvt_rows_i8(const float* __restrict__ src, unsigned char* __restrict__ dst, float* __restrict__ scale_out, size_t n16, size_t gtid, size_t gsz) {
  for (size_t i = gtid; i < n16; i += gsz) {
    const float4 a = *(const float4*)(src + i * 16), b = *(const float4*)(src + i * 16 + 4), c = *(const float4*)(src + i * 16 + 8), d = *(const float4*)(src + i * 16 + 12);
    float m = fmaxf(fmaxf(fmaxf(fabsf(a.x), fabsf(a.y)), fmaxf(fabsf(a.z), fabsf(a.w))), fmaxf(fmaxf(fabsf(b.x), fabsf(b.y)), fmaxf(fabsf(b.z), fabsf(b.w))));
    m = fmaxf(m, fmaxf(fmaxf(fmaxf(fabsf(c.x), fabsf(c.y)), fmaxf(fabsf(c.z), fabsf(c.w))), fmaxf(fmaxf(fabsf(d.x), fabsf(d.y)), fmaxf(fabsf(d.z), fabsf(d.w)))));
#pragma unroll
    for (int o = 32; o > 0; o >>= 1) m = fmaxf(m, __shfl_xor(m, o, 64));
    m = fmaxf(m, 1e-30f);
    const float q = 127.f / m;
    uint4 r;
    r.x = pk4_i8(a.x * q, a.y * q, a.z * q, a.w * q); r.y = pk4_i8(b.x * q, b.y * q, b.z * q, b.w * q);
    r.z = pk4_i8(c.x * q, c.y * q, c.z * q, c.w * q); r.w = pk4_i8(d.x * q, d.y * q, d.z * q, d.w * q);
    *(uint4*)(dst + i * 16) = r;
    if ((i & 63) == 0) scale_out[i >> 6] = m * (1.f / 127.f);
  }
}
DI void cvt_transpose(const float* __restrict__ src, u16* __restrict__ dst, int K, int N, size_t gtid, size_t gsz) {
  const size_t total = (size_t)N * (K / 8);
  for (size_t i = gtid; i < total; i += gsz) {
    const int n = (int)(i % N), k8 = (int)(i / N);
    float v[8];
#pragma unroll
    for (int j = 0; j < 8; ++j) v[j] = src[(size_t)(k8 * 8 + j) * N + n];
    uint4 r; r.x = pack2(v[0], v[1]); r.y = pack2(v[2], v[3]); r.z = pack2(v[4], v[5]); r.w = pack2(v[6], v[7]);
    *(uint4*)(dst + (size_t)n * K + k8 * 8) = r;
  }
}

constexpr int STAGE_BYTES = 384 * 128;

typedef __attribute__((address_space(3))) unsigned lds_u32;
template <int WM>
DI void gemm_tile(const u16* __restrict__ A, const u16* __restrict__ Bt, const int K, const int m0, const int n0, char* smem, f32x4 (&acc)[4][4]) {
  constexpr int BM = 64 * WM;
  const int tid = threadIdx.x, lane = tid & 63, w = __builtin_amdgcn_readfirstlane(tid >> 6);
  const int wm = w % WM, wn = w / WM;
  const int g = lane >> 4, r16 = lane & 15;
#pragma unroll
  for (int i = 0; i < 4; ++i)
#pragma unroll
    for (int j = 0; j < 4; ++j) acc[i][j] = f32x4{0.f, 0.f, 0.f, 0.f};
  const int srow = tid >> 3, sc = tid & 7;
  const u16* gp[6];
#pragma unroll
  for (int i = 0; i < 6; ++i) {
    const int row = srow + 64 * i;
    const int c = sc ^ ((row >> 1) & 7);
    gp[i] = (i < WM) ? (A + (size_t)(m0 + row) * K + c * 8) : (Bt + (size_t)(n0 + row - BM) * K + c * 8);
  }
  lds_u32* lbase = (lds_u32*)(smem + tid * 16);
#define STAGE(KOFF, BUF) do { \
    _Pragma("unroll") for (int i = 0; i < 6; ++i) \
      __builtin_amdgcn_global_load_lds((const unsigned*)(gp[i] + (KOFF)), (lds_u32*)((__attribute__((address_space(3))) char*)lbase + (BUF) * STAGE_BYTES + i * 8192), 16, 0, 0); } while (0)
  const int KT = K / 64;
  STAGE(0, 0);
  STAGE(64, 1);
  for (int kt = 0; kt < KT; ++kt) {
    asm volatile("s_waitcnt vmcnt(6)" ::: "memory");
    __builtin_amdgcn_s_barrier();
    const int kn = (kt + 2 < KT ? kt + 2 : KT - 1) * 64;
    const int bn = (kt + 2) % 3, bc = kt % 3;
    STAGE(kn, bn);
    const char* cur = smem + bc * STAGE_BYTES;
    bf16x8 af[2][4], bfr[2][4];
#pragma unroll
    for (int kk = 0; kk < 2; ++kk) {
      const int c = 4 * kk + g;
#pragma unroll
      for (int mi = 0; mi < 4; ++mi) { const int row = 64 * wm + 16 * mi + r16; af[kk][mi] = *(const bf16x8*)(cur + row * 128 + ((c ^ ((row >> 1) & 7)) << 4)); }
#pragma unroll
      for (int ni = 0; ni < 4; ++ni) { const int row = BM + 64 * wn + 16 * ni + r16; bfr[kk][ni] = *(const bf16x8*)(cur + row * 128 + ((c ^ ((row >> 1) & 7)) << 4)); }
    }
#pragma unroll
    for (int kk = 0; kk < 2; ++kk)
#pragma unroll
      for (int mi = 0; mi < 4; ++mi)
#pragma unroll
        for (int ni = 0; ni < 4; ++ni) acc[mi][ni] = MFMA16(af[kk][mi], bfr[kk][ni], acc[mi][ni]);
  }
#undef STAGE
  asm volatile("s_waitcnt vmcnt(0)" ::: "memory");
  __syncthreads();
}

template <int MMG>
DI void tile_coords(const int lin, const int k, const int MT, const int NTN, int& mt, int& nt) {
  const int G = gridDim.x, total = MT * NTN;
  if ((G & 7) == 0 && total % G == 0 && (MT & 7) == 0 && ((MT >> 3) % MMG) == 0) {
    const int x = blockIdx.x & 7, r = blockIdx.x >> 3, q = r + (G >> 3) * k;
    const int mm = q % MMG, rest = q / MMG;
    nt = rest % NTN;
    mt = x * (MT >> 3) + (rest / NTN) * MMG + mm;
  } else { mt = lin / NTN; nt = lin % NTN; }
}

constexpr int CT_PITCH = 132;
DI void stage_acc(const f32x4 (&acc)[4][4], char* smem, const int wm, const int wn, const int g, const int r16) {
  float* ct = (float*)smem;
#pragma unroll
  for (int mi = 0; mi < 4; ++mi)
#pragma unroll
    for (int ni = 0; ni < 4; ++ni)
#pragma unroll
      for (int j = 0; j < 4; ++j) ct[(64 * wm + 16 * mi + 4 * g + j) * CT_PITCH + 64 * wn + 16 * ni + r16] = acc[mi][ni][j];
}

constexpr int BIG_STAGE = 512 * 128;
DI void gemm_tile_big(const u16* __restrict__ A, const u16* __restrict__ Bt, const int K, const int m0, const int n0, char* smem, f32x4 (&acc)[8][4]) {
  const int tid = threadIdx.x, lane = tid & 63, w = __builtin_amdgcn_readfirstlane(tid >> 6);
  const int wm = w & 1, wn = w >> 1;
  const int g = lane >> 4, r16 = lane & 15;
#pragma unroll
  for (int i = 0; i < 8; ++i)
#pragma unroll
    for (int j = 0; j < 4; ++j) acc[i][j] = f32x4{0.f, 0.f, 0.f, 0.f};
  const int srow = tid >> 3, sc = tid & 7;
  const int c = sc ^ ((srow >> 1) & 7);
  const u16* ga = A + (size_t)(m0 + srow) * K + c * 8;
  const u16* gb = Bt + (size_t)(n0 + srow) * K + c * 8;
  const size_t rs = (size_t)64 * K;
  __attribute__((address_space(3))) char* lbase = (__attribute__((address_space(3))) char*)(smem + tid * 16);
#define STAGEB(KOFF, BUF) do { \
    _Pragma("unroll") for (int i = 0; i < 4; ++i) { \
      __builtin_amdgcn_global_load_lds((const unsigned*)(ga + i * rs + (KOFF)), (lds_u32*)(lbase + (BUF) * BIG_STAGE + i * 8192), 16, 0, 0); \
      __builtin_amdgcn_global_load_lds((const unsigned*)(gb + i * rs + (KOFF)), (lds_u32*)(lbase + (BUF) * BIG_STAGE + 32768 + i * 8192), 16, 0, 0); } } while (0)
  const int KT = K / 64;
  STAGEB(0, 0);
  asm volatile("s_waitcnt vmcnt(0)" ::: "memory");
  __builtin_amdgcn_s_barrier();
#pragma unroll 1
  for (int kt = 0; kt < KT; ++kt) {
    STAGEB((kt + 1 < KT ? kt + 1 : kt) * 64, (kt + 1) & 1);
    const char* cur = smem + (kt & 1) * BIG_STAGE;
#pragma unroll
    for (int kk = 0; kk < 2; ++kk) {
      const int cc = 4 * kk + g;
      bf16x8 bfr[4];
#pragma unroll
      for (int ni = 0; ni < 4; ++ni) { const int row = 256 + 64 * wn + 16 * ni + r16; bfr[ni] = *(const bf16x8*)(cur + row * 128 + ((cc ^ ((row >> 1) & 7)) << 4)); }
#pragma unroll
      for (int mi = 0; mi < 8; ++mi) {
        const int row = 128 * wm + 16 * mi + r16;
        const bf16x8 af = *(const bf16x8*)(cur + row * 128 + ((cc ^ ((row >> 1) & 7)) << 4));
#pragma unroll
        for (int ni = 0; ni < 4; ++ni) acc[mi][ni] = MFMA16(af, bfr[ni], acc[mi][ni]);
      }
    }
    asm volatile("s_waitcnt vmcnt(0)" ::: "memory");
    __builtin_amdgcn_s_barrier();
  }
#undef STAGEB
}
template <int HF>
DI void stage_acc_big(const f32x4 (&acc)[8][4], char* smem, const int g, const int r16) {
  const int w = __builtin_amdgcn_readfirstlane(threadIdx.x >> 6), wm = w & 1, wn = w >> 1;
  if ((wn >> 1) != HF) return;
  float* ct = (float*)smem;
#pragma unroll
  for (int mi = 0; mi < 8; ++mi)
#pragma unroll
    for (int ni = 0; ni < 4; ++ni)
#pragma unroll
      for (int j = 0; j < 4; ++j) ct[(128 * wm + 16 * mi + 4 * g + j) * CT_PITCH + 64 * (wn & 1) + 16 * ni + r16] = acc[mi][ni][j];
}

template <int D> DI size_t attn_kidx(int bh, int s, int d) {
  const int r = s % D, l = s / D;
  return ((size_t)((bh * D + r) * (128 / D) + (l >> 4)) * 8 + (d >> 3)) * 128 + (l & 15) * 8 + (d & 7);
}
template <int D> DI size_t attn_vidx(int bh, int s, int d) {
  const int r = s % D, l = s / D;
  return ((size_t)((bh * D + r) * (128 / D) + (l >> 4)) * 64 + d) * 16 + (l & 15);
}

DI void inproj_epilogue(const Params& p, const char* smem, const int m0, const int n0) {
  u16* pu = (u16*)(p.ws + WS_PU); u16* qb = (u16*)(p.ws + WS_Q); u16* kb = (u16*)(p.ws + WS_K); u16* vT = (u16*)(p.ws + WS_VT);
  u16* vT4 = (u16*)(p.ws + WS_VT4); u16* vT16 = (u16*)(p.ws + WS_VT16); u16* k4 = (u16*)(p.ws + WS_K4); u16* k16 = (u16*)(p.ws + WS_K16);
  const float* ct = (const float*)smem;
  if (n0 < 1536) {
    u16* dst = n0 < 1024 ? (pu + (size_t)m0 * 1024 + n0) : (qb + (size_t)m0 * 512 + (n0 - 1024));
    const int ld = n0 < 1024 ? 1024 : 512;
#pragma unroll 4
    for (int i = 0; i < 16; ++i) {
      const int c = threadIdx.x + NT * i, row = c >> 5, ch = c & 31;
      const float4 y = *(const float4*)(ct + row * CT_PITCH + 4 * ch), bv = *(const float4*)(p.b_in + n0 + 4 * ch);
      uint2 r; r.x = pack2(y.x + bv.x, y.y + bv.y); r.y = pack2(y.z + bv.z, y.w + bv.w);
      *(uint2*)(dst + (size_t)row * ld + 4 * ch) = r;
    }
    return;
  }
  const int bbase = (m0 >> 11) * 8, s0 = m0 & 2047;
  if (n0 < 2048) {
    const int cc0 = n0 - 1536;
#pragma unroll 2
    for (int i = 0; i < 8; ++i) {
      const int q = threadIdx.x + NT * i, row = q >> 4, ch16 = q & 15;
      const float4 y0 = *(const float4*)(ct + row * CT_PITCH + 8 * ch16), y1 = *(const float4*)(ct + row * CT_PITCH + 8 * ch16 + 4);
      const float4 b0 = *(const float4*)(p.b_in + n0 + 8 * ch16), b1 = *(const float4*)(p.b_in + n0 + 8 * ch16 + 4);
      uint4 r; r.x = pack2(y0.x + b0.x, y0.y + b0.y); r.y = pack2(y0.z + b0.z, y0.w + b0.w); r.z = pack2(y1.x + b1.x, y1.y + b1.y); r.w = pack2(y1.z + b1.z, y1.w + b1.w);
      const int cc = cc0 + 8 * ch16, bh = bbase + (cc >> 6), d = cc & 63, s = s0 + row;
      *(uint4*)(kb + attn_kidx<1>(bh, s, d)) = r;
      *(uint4*)(k4 + attn_kidx<4>(bh, s, d)) = r;
      *(uint4*)(k16 + attn_kidx<16>(bh, s, d)) = r;
    }
  } else {
    const int cc0 = n0 - 2048;
#pragma unroll 2
    for (int i = 0; i < 8; ++i) {
      const int q = threadIdx.x + NT * i, col = q & 127, cidx = q >> 7;
      const float bias = p.b_in[n0 + col];
      const int cc = cc0 + col, bh = bbase + (cc >> 6), d = cc & 63;
#define V_CHUNK(D, DST) do { \
        const int r_ = cidx % (D), l8_ = (cidx / (D)) * 8; \
        float e_[8]; \
        _Pragma("unroll") for (int j = 0; j < 8; ++j) e_[j] = ct[((D) * (l8_ + j) + r_) * CT_PITCH + col] + bias; \
        uint4 w_; w_.x = pack2(e_[0], e_[1]); w_.y = pack2(e_[2], e_[3]); w_.z = pack2(e_[4], e_[5]); w_.w = pack2(e_[6], e_[7]); \
        *(uint4*)((DST) + attn_vidx<D>(bh, s0 + (D) * l8_ + r_, d)) = w_; } while (0)
      V_CHUNK(1, vT);
      V_CHUNK(4, vT4);
      V_CHUNK(16, vT16);
#undef V_CHUNK
    }
  }
}

DI void phase_inproj(const Params& p, char* smem) {
  const u16* xb = (const u16*)(p.ws + WS_XB);
  const u16* wt = (const u16*)(p.ws + WS_WIN);
  const int lane = threadIdx.x & 63, g = lane >> 4, r16 = lane & 15;
  const int NTN = NPROJ / 256;
  for (int tile = blockIdx.x, kit = 0; tile < (T / 256) * NTN; tile += gridDim.x, ++kit) {
    int mt_, nt_; tile_coords<4>(tile, kit, T / 256, NTN, mt_, nt_);
    const int m0 = mt_ * 256, n0 = nt_ * 256;
    {
      const size_t vt_ = (size_t)tile * NT + threadIdx.x, vsz_ = (size_t)(T / 256) * NTN * NT;
      cvt_transpose(p.w_out, (u16*)(p.ws + WS_WOUT), DM, DM, vt_, vsz_);
      cvt_transpose(p.wq, (u16*)(p.ws + WS_WQ), DM, 2048, vt_, vsz_);
    }
    f32x4 acc[8][4];
    gemm_tile_big(xb, wt, DM, m0, n0, smem, acc);
    stage_acc_big<0>(acc, smem, g, r16);
    __syncthreads();
    inproj_epilogue(p, smem, m0, n0);
    __syncthreads();
    stage_acc_big<1>(acc, smem, g, r16);
    __syncthreads();
    inproj_epilogue(p, smem, m0, n0 + 128);
    __syncthreads();
  }
}

template <int D>
DI void attn_task2(const u16* __restrict__ qb, const u16* __restrict__ kd, const u16* __restrict__ vTd, const int b, const int h,
                   const int rA, const int l0A, const int rB, const int l0B, const float c2, f32x4 (&O)[2][4], float (&m_out)[2], float (&l_out)[2]) {
  const int lane = threadIdx.x & 63, g = lane >> 4, i16 = lane & 15;
  const float c1 = 0.125f * LOG2E;
  const float c2d = c2 * (float)D;
  int nsteps = (l0A + 16 + 31) >> 5;
  nsteps = nsteps > 5 ? 5 : nsteps;
  int l0[2] = {l0A, l0B}, lq[2], first[2], bhr[2];
  bf16x8 qf[2][2];
  float m[2] = {-1e30f, -1e30f}, l[2] = {0.f, 0.f};
#pragma unroll
  for (int z = 0; z < 2; ++z) {
    const int r = z ? rB : rA;
    lq[z] = l0[z] + i16;
    const int tq = D * lq[z] + r;
#pragma unroll
    for (int kk = 0; kk < 2; ++kk) qf[z][kk] = *(const bf16x8*)(qb + (size_t)(b * SEQ + tq) * 512 + h * 64 + 8 * g + 32 * kk);
#pragma unroll
    for (int c = 0; c < 4; ++c) O[z][c] = f32x4{0.f, 0.f, 0.f, 0.f};
    first[z] = l0[z] + 16 - 32 * nsteps;
    bhr[z] = ((b * 8 + h) * D + r) * (128 / D);
  }
  bf16x8 kf[2][2][2], vf[2][4];
#define ATTN_LOAD(Z, LK0, KF, VF) do { \
    const int g0_ = (LK0) >> 4; \
    _Pragma("unroll") for (int u = 0; u < 2; ++u) { \
      const int sl_ = 8 * (i16 >> 2) + 4 * u + (i16 & 3); \
      int gk_ = g0_ + (sl_ >> 4); gk_ = gk_ < 0 ? 0 : gk_; \
      const u16* kp_ = kd + ((size_t)(bhr[Z] + gk_) * 8 + g) * 128 + (sl_ & 15) * 8; \
      _Pragma("unroll") for (int kk = 0; kk < 2; ++kk) KF[u][kk] = *(const bf16x8*)(kp_ + (size_t)kk * 512); \
    } \
    { int gv_ = g0_ + (g >> 1); gv_ = gv_ < 0 ? 0 : gv_; \
      const u16* vp_ = vTd + ((size_t)(bhr[Z] + gv_) * 64 + i16) * 16 + 8 * (g & 1); \
      _Pragma("unroll") for (int c = 0; c < 4; ++c) VF[c] = *(const bf16x8*)(vp_ + c * 256); } \
  } while (0)
  for (int st = 0; st < nsteps; ++st) {
    ATTN_LOAD(0, first[0] + 32 * st, kf[0], vf[0]);
    ATTN_LOAD(1, first[1] + 32 * st, kf[1], vf[1]);
#pragma unroll
    for (int z = 0; z < 2; ++z) {
      const int lk0 = first[z] + 32 * st;
      f32x4 sa[2];
#pragma unroll
      for (int u = 0; u < 2; ++u) {
        sa[u] = MFMA16(kf[z][u][0], qf[z][0], (f32x4{0.f, 0.f, 0.f, 0.f}));
        sa[u] = MFMA16(kf[z][u][1], qf[z][1], sa[u]);
      }
      float s[8];
      float mx = -1e30f;
      const bool interior = (lk0 >= 0) && (l0[z] - lk0 >= 31) && (l0[z] + 15 - lk0 <= 128);
      const float dl0 = (float)(lq[z] - lk0 - 8 * g);
      if (interior) {
#pragma unroll
        for (int u = 0; u < 2; ++u)
#pragma unroll
          for (int j = 0; j < 4; ++j) {
            const float sv = sa[u][j] * c1 - c2d * (dl0 - (float)(4 * u + j));
            s[4 * u + j] = sv;
            mx = fmaxf(mx, sv);
          }
      } else {
#pragma unroll
        for (int u = 0; u < 2; ++u)
#pragma unroll
          for (int j = 0; j < 4; ++j) {
            const int lk = lk0 + 8 * g + 4 * u + j;
            const int dl = lq[z] - lk;
            const bool valid = (dl >= 0) && (dl <= 128) && (lk >= 0);
            const float sv = valid ? (sa[u][j] * c1 - c2d * (float)dl) : -1e30f;
            s[4 * u + j] = sv;
            mx = fmaxf(mx, sv);
          }
      }
      mx = fmaxf(mx, __shfl_xor(mx, 16, 64));
      mx = fmaxf(mx, __shfl_xor(mx, 32, 64));
      const float mn = fmaxf(m[z], mx);
      const float al = __builtin_amdgcn_exp2f(m[z] - mn);
      m[z] = mn;
      float ps = 0.f;
      float pv[8];
      if (interior) {
#pragma unroll
        for (int e = 0; e < 8; ++e) { pv[e] = __builtin_amdgcn_exp2f(s[e] - mn); ps += pv[e]; }
      } else {
#pragma unroll
        for (int e = 0; e < 8; ++e) { pv[e] = (s[e] > -1e29f) ? __builtin_amdgcn_exp2f(s[e] - mn) : 0.f; ps += pv[e]; }
      }
      l[z] = l[z] * al + ps;
#pragma unroll
      for (int c = 0; c < 4; ++c) O[z][c] = O[z][c] * al;
      union { bf16x8 v; unsigned u[4]; } pf;
      pf.u[0] = pack2(pv[0], pv[1]); pf.u[1] = pack2(pv[2], pv[3]); pf.u[2] = pack2(pv[4], pv[5]); pf.u[3] = pack2(pv[6], pv[7]);
#pragma unroll
      for (int c = 0; c < 4; ++c) O[z][c] = MFMA16(vf[z][c], pf.v, O[z][c]);
    }
  }
#undef ATTN_LOAD
#pragma unroll
  for (int z = 0; z < 2; ++z) {
    float lz = l[z];
    lz += __shfl_xor(lz, 16, 64);
    lz += __shfl_xor(lz, 32, 64);
    m_out[z] = m[z]; l_out[z] = lz;
  }
}

constexpr int AST_PITCH = 68;
DI float* ast_ptr(float* Ost, int pos, int c, int g) { return Ost + pos * AST_PITCH + 4 * ((4 * c + g) ^ ((pos >> 4) & 15)); }

DI void phase_attn(const Params& p, char* smem) {
  const u16* qb = (const u16*)(p.ws + WS_Q); const u16* kb = (const u16*)(p.ws + WS_K);
  const u16* vT1 = (const u16*)(p.ws + WS_VT); const u16* vT4 = (const u16*)(p.ws + WS_VT4); const u16* vT16 = (const u16*)(p.ws + WS_VT16);
  const u16* k4 = (const u16*)(p.ws + WS_K4); const u16* k16 = (const u16*)(p.ws + WS_K16);
  u16* mix = (u16*)(p.ws + WS_MIX);
  float* Ost = (float*)smem; float* mst = Ost + 256 * AST_PITCH; float* lst = mst + 256;
  const int lane = threadIdx.x & 63, w = __builtin_amdgcn_readfirstlane(threadIdx.x >> 6), g = lane >> 4, i16 = lane & 15;
  for (int item = blockIdx.x; item < 1024; item += gridDim.x) {
    {
      const size_t vt_ = (size_t)item * NT + threadIdx.x, vsz_ = (size_t)1024 * NT;
      cvt_rows_i8(p.ut, p.ws + WS_UB, (float*)(p.ws + WS_SU), (size_t)16384 * DM / 16, vt_, vsz_);
      cvt_linear_fp8(p.vt, p.ws + WS_VB, (size_t)16384 * DM / 16, V_SCALE, vt_, vsz_);
    }
    const int qblk = 7 - (item >> 7), bh = item & 127, b = bh >> 3, h = bh & 7;
    const int t0 = qblk * 256;
    const float c2 = exp2f(-(float)(h + 1)) * LOG2E;
    {
      f32x4 O[2][4]; float m[2], l[2];
      attn_task2<1>(qb, kb, vT1, b, h, 0, t0 + 32 * w, 0, t0 + 32 * w + 16, c2, O, m, l);
#pragma unroll
      for (int z = 0; z < 2; ++z) {
        const int pos = 16 * (2 * w + z) + i16;
#pragma unroll
        for (int c = 0; c < 4; ++c) *(f32x4*)ast_ptr(Ost, pos, c, g) = O[z][c];
        if (g == 0) { mst[pos] = m[z]; lst[pos] = l[z]; }
      }
    }
    __syncthreads();
    {
      const int i = (2 * w) >> 2, r0 = (2 * w) & 3;
      f32x4 O[2][4]; float m[2], l[2];
      attn_task2<4>(qb, k4, vT4, b, h, r0, (t0 >> 2) + 16 * i, r0 + 1, (t0 >> 2) + 16 * i, c2, O, m, l);
#pragma unroll
      for (int z = 0; z < 2; ++z) {
        const int pos = 64 * i + 4 * i16 + r0 + z;
        const float mo = mst[pos], lo = lst[pos];
        const float mn = fmaxf(mo, m[z]), ao = __builtin_amdgcn_exp2f(mo - mn), an = __builtin_amdgcn_exp2f(m[z] - mn);
#pragma unroll
        for (int c = 0; c < 4; ++c) { float* q = ast_ptr(Ost, pos, c, g); const f32x4 old = *(const f32x4*)q; *(f32x4*)q = old * ao + O[z][c] * an; }
        if (g == 0) { mst[pos] = mn; lst[pos] = lo * ao + l[z] * an; }
      }
    }
    __syncthreads();
    {
      f32x4 O[2][4]; float m[2], l[2];
      attn_task2<16>(qb, k16, vT16, b, h, 2 * w, t0 >> 4, 2 * w + 1, t0 >> 4, c2, O, m, l);
#pragma unroll
      for (int z = 0; z < 2; ++z) {
        const int pos = 16 * i16 + 2 * w + z;
        const float mo = mst[pos], lo = lst[pos];
        const float mn = fmaxf(mo, m[z]), ao = __builtin_amdgcn_exp2f(mo - mn), an = __builtin_amdgcn_exp2f(m[z] - mn);
        const float inv = 1.f / (lo * ao + l[z] * an);
        u16* orow = mix + (size_t)(b * SEQ + t0 + pos) * 1024 + 512 + h * 64 + 4 * g;
#pragma unroll
        for (int c = 0; c < 4; ++c) {
          const f32x4 old = *(const f32x4*)ast_ptr(Ost, pos, c, g);
          const f32x4 o = (old * ao + O[z][c] * an) * inv;
          uint2 v; v.x = pack2(o[0], o[1]); v.y = pack2(o[2], o[3]);
          *(uint2*)(orow + 16 * c) = v;
        }
      }
    }
    __syncthreads();
  }
}

DI void phase_conv(const Params& p, char* smem) {
  const u16* pu = (const u16*)(p.ws + WS_PU);
  u16* mix = (u16*)(p.ws + WS_MIX);
  u16* glu = (u16*)smem;
  const int tid = threadIdx.x, lane = tid & 63, w = __builtin_amdgcn_readfirstlane(tid >> 6);
  for (int item = blockIdx.x; item < 512; item += gridDim.x) {
    const int b = item >> 5, s0 = (item & 31) * 64;
    __syncthreads();
    for (int q = tid; q < 94 * 64; q += NT) {
      const int row = q >> 6, c8 = q & 63;
      const int s = s0 - 30 + row;
      uint4 r = uint4{0u, 0u, 0u, 0u};
      if (s >= 0) {
        const u16* src = pu + (size_t)(b * SEQ + s) * 1024 + c8 * 8;
        const uint4 a = *(const uint4*)src, gt = *(const uint4*)(src + 512);
        const unsigned aw[4] = {a.x, a.y, a.z, a.w}, gw[4] = {gt.x, gt.y, gt.z, gt.w};
        unsigned ow[4];
#pragma unroll
        for (int k = 0; k < 4; ++k) {
          const float a0 = bflo(aw[k]), a1 = bfhi(aw[k]), g0 = bflo(gw[k]), g1 = bfhi(gw[k]);
          ow[k] = pack2(a0 / (1.f + __expf(-g0)), a1 / (1.f + __expf(-g1)));
        }
        r = uint4{ow[0], ow[1], ow[2], ow[3]};
      }
      *(uint4*)(glu + row * 512 + c8 * 8) = r;
    }
    __syncthreads();
    float acc[8][8];
    {
      const float4 b0 = *(const float4*)(p.conv_b + lane * 8), b1 = *(const float4*)(p.conv_b + lane * 8 + 4);
#pragma unroll
      for (int i = 0; i < 8; ++i) { acc[i][0] = b0.x; acc[i][1] = b0.y; acc[i][2] = b0.z; acc[i][3] = b0.w; acc[i][4] = b1.x; acc[i][5] = b1.y; acc[i][6] = b1.z; acc[i][7] = b1.w; }
    }
#pragma unroll 4
    for (int j = 0; j < 31; ++j) {
      const float4 w0 = *(const float4*)(p.conv_w + j * 512 + lane * 8), w1 = *(const float4*)(p.conv_w + j * 512 + lane * 8 + 4);
      const float wj[8] = {w0.x, w0.y, w0.z, w0.w, w1.x, w1.y, w1.z, w1.w};
#pragma unroll
      for (int i = 0; i < 8; ++i) {
        const uint4 v = *(const uint4*)(glu + (8 * w + i + j) * 512 + lane * 8);
        acc[i][0] += wj[0] * bflo(v.x); acc[i][1] += wj[1] * bfhi(v.x);
        acc[i][2] += wj[2] * bflo(v.y); acc[i][3] += wj[3] * bfhi(v.y);
        acc[i][4] += wj[4] * bflo(v.z); acc[i][5] += wj[5] * bfhi(v.z);
        acc[i][6] += wj[6] * bflo(v.w); acc[i][7] += wj[7] * bfhi(v.w);
      }
    }
    const float4 g0 = *(const float4*)(p.cln_g + lane * 8), g1 = *(const float4*)(p.cln_g + lane * 8 + 4);
    const float4 c0 = *(const float4*)(p.cln_b + lane * 8), c1 = *(const float4*)(p.cln_b + lane * 8 + 4);
    const float gg[8] = {g0.x, g0.y, g0.z, g0.w, g1.x, g1.y, g1.z, g1.w};
    const float cb[8] = {c0.x, c0.y, c0.z, c0.w, c1.x, c1.y, c1.z, c1.w};
#pragma unroll
    for (int i = 0; i < 8; ++i) {
      float sm = 0.f;
#pragma unroll
      for (int k = 0; k < 8; ++k) sm += acc[i][k];
      const float mean = wave_sum(sm) * (1.f / 512.f);
      float sq = 0.f;
#pragma unroll
      for (int k = 0; k < 8; ++k) { const float d = acc[i][k] - mean; sq += d * d; }
      const float rstd = rsqrtf(wave_sum(sq) * (1.f / 512.f) + LN_EPS);
      float o[8];
#pragma unroll
      for (int k = 0; k < 8; ++k) { const float y = (acc[i][k] - mean) * rstd * gg[k] + cb[k]; o[k] = y / (1.f + __expf(-y)); }
      uint4 r; r.x = pack2(o[0], o[1]); r.y = pack2(o[2], o[3]); r.z = pack2(o[4], o[5]); r.w = pack2(o[6], o[7]);
      *(uint4*)(mix + (size_t)(b * SEQ + s0 + 8 * w + i) * 1024 + lane * 8) = r;
    }
  }
}

DI void outproj_epilogue(const Params& p, const char* smem, const int m0, const int n0) {
  u16* rbuf = (u16*)(p.ws + WS_PU);
  const u16* xb = (const u16*)(p.ws + WS_XB);
  const float* ct = (const float*)smem;
#pragma unroll 4
  for (int i = 0; i < 16; ++i) {
    const int c = threadIdx.x + NT * i, row = c >> 5, ch = c & 31;
    const float4 y = *(const float4*)(ct + row * CT_PITCH + 4 * ch);
    const size_t o = (size_t)(m0 + row) * 1024 + n0 + 4 * ch;
    const uint2 xq = *(const uint2*)(xb + o); const float4 xv = float4{bflo(xq.x), bfhi(xq.x), bflo(xq.y), bfhi(xq.y)}, bv = *(const float4*)(p.b_out + n0 + 4 * ch);
    uint2 r; r.x = pack2(ALPHA * xv.x + y.x + bv.x, ALPHA * xv.y + y.y + bv.y); r.y = pack2(ALPHA * xv.z + y.z + bv.z, ALPHA * xv.w + y.w + bv.w);
    *(uint2*)(rbuf + o) = r;
  }
}
DI void phase_outproj(const Params& p, char* smem) {
  const u16* mix = (const u16*)(p.ws + WS_MIX);
  const u16* wt = (const u16*)(p.ws + WS_WOUT);
  const int lane = threadIdx.x & 63, g = lane >> 4, r16 = lane & 15;
  const int NTN = DM / 256;
  for (int tile = blockIdx.x, kit = 0; tile < (T / 256) * NTN; tile += gridDim.x, ++kit) {
    int mt_, nt_; tile_coords<4>(tile, kit, T / 256, NTN, mt_, nt_);
    const int m0 = mt_ * 256, n0b = nt_ * 256;
    f32x4 acc[8][4];
    gemm_tile_big(mix, wt, DM, m0, n0b, smem, acc);
    stage_acc_big<0>(acc, smem, g, r16);
    __syncthreads();
    outproj_epilogue(p, smem, m0, n0b);
    __syncthreads();
    stage_acc_big<1>(acc, smem, g, r16);
    __syncthreads();
    outproj_epilogue(p, smem, m0, n0b + 128);
    __syncthreads();
  }
}

DI void phase_ln1(const Params& p) {
  const u16* rbuf = (const u16*)(p.ws + WS_PU);
  u16* h1b = (u16*)(p.ws + WS_XB);
  unsigned char* h1f8 = p.ws + WS_H1F8;
  const int lane = threadIdx.x & 63, w = __builtin_amdgcn_readfirstlane(threadIdx.x >> 6);
  float4 gg[4], bb[4];
#pragma unroll
  for (int k = 0; k < 4; ++k) { gg[k] = *(const float4*)(p.ln1_g + 256 * k + 4 * lane); bb[k] = *(const float4*)(p.ln1_b + 256 * k + 4 * lane); }
  for (int tb = blockIdx.x; tb < T / 8; tb += 2 * gridDim.x) {
    const int tb1 = tb + (int)gridDim.x < T / 8 ? tb + (int)gridDim.x : tb;
    const int tt[2] = {tb * 8 + w, tb1 * 8 + w};
    float4 v[2][4];
#pragma unroll
    for (int z = 0; z < 2; ++z)
#pragma unroll
      for (int k = 0; k < 4; ++k) {
        const uint2 q = *(const uint2*)(rbuf + (size_t)tt[z] * 1024 + 256 * k + 4 * lane);
        v[z][k] = float4{bflo(q.x), bfhi(q.x), bflo(q.y), bfhi(q.y)};
      }
#pragma unroll
    for (int z = 0; z < 2; ++z) {
      const int t = tt[z];
      float sm = 0.f;
#pragma unroll
      for (int k = 0; k < 4; ++k) sm += v[z][k].x + v[z][k].y + v[z][k].z + v[z][k].w;
      const float mean = wave_sum(sm) * (1.f / 1024.f);
      float sq = 0.f;
#pragma unroll
      for (int k = 0; k < 4; ++k) { float d; d = v[z][k].x - mean; sq += d * d; d = v[z][k].y - mean; sq += d * d; d = v[z][k].z - mean; sq += d * d; d = v[z][k].w - mean; sq += d * d; }
      const float rstd = rsqrtf(wave_sum(sq) * (1.f / 1024.f) + LN_EPS);
      float4 o[4];
      float am = 0.f;
#pragma unroll
      for (int k = 0; k < 4; ++k) {
        const int d0 = 256 * k + 4 * lane;
        o[k].x = (v[z][k].x - mean) * rstd * gg[k].x + bb[k].x; o[k].y = (v[z][k].y - mean) * rstd * gg[k].y + bb[k].y;
        o[k].z = (v[z][k].z - mean) * rstd * gg[k].z + bb[k].z; o[k].w = (v[z][k].w - mean) * rstd * gg[k].w + bb[k].w;
        am = fmaxf(am, fmaxf(fmaxf(fabsf(o[k].x), fabsf(o[k].y)), fmaxf(fabsf(o[k].z), fabsf(o[k].w))));
        uint2 hb; hb.x = pack2(o[k].x, o[k].y); hb.y = pack2(o[k].z, o[k].w);
        *(uint2*)(h1b + (size_t)t * 1024 + d0) = hb;
      }
#pragma unroll
      for (int of = 32; of > 0; of >>= 1) am = fmaxf(am, __shfl_xor(am, of, 64));
      am = fmaxf(am, 1e-30f);
      const float q = 127.f / am;
#pragma unroll
      for (int k = 0; k < 4; ++k) *(unsigned*)(h1f8 + (size_t)t * 1024 + 256 * k + 4 * lane) = pk4_i8(o[k].x * q, o[k].y * q, o[k].z * q, o[k].w * q);
      if (lane == 0) ((float*)(p.ws + WS_SX))[t] = am * (1.f / 127.f);
    }
  }
}

DI unsigned enc_key(float s) { const unsigned u = __float_as_uint(s); return (u & 0x80000000u) ? ~u : (u | 0x80000000u); }
DI float dec_key(unsigned k) { const unsigned u = (k & 0x80000000u) ? (k & 0x7fffffffu) : ~k; return __uint_as_float(u); }
DI void cswap(unsigned& a, unsigned& b) { const unsigned hi = a > b ? a : b, lo = a > b ? b : a; a = hi; b = lo; }

DI void sort16_desc(unsigned (&v)[16]) {
  constexpr int KS[10] = {2, 4, 4, 8, 8, 8, 16, 16, 16, 16};
  constexpr int JS[10] = {1, 2, 1, 4, 2, 1, 8, 4, 2, 1};
#pragma unroll
  for (int s = 0; s < 10; ++s) {
#pragma unroll
    for (int i = 0; i < 16; ++i) {
      const int l = i ^ JS[s];
      if (l > i) {
        if ((i & KS[s]) == 0) cswap(v[i], v[l]); else cswap(v[l], v[i]);
      }
    }
  }
}
DI void merge16_desc(unsigned (&R)[16], const unsigned (&X)[16]) {
#pragma unroll
  for (int i = 0; i < 16; ++i) R[i] = R[i] > X[15 - i] ? R[i] : X[15 - i];
  constexpr int JS[4] = {8, 4, 2, 1};
#pragma unroll
  for (int s = 0; s < 4; ++s) {
#pragma unroll
    for (int i = 0; i < 16; ++i) {
      const int l = i ^ JS[s];
      if (l > i) cswap(R[i], R[l]);
    }
  }
}

struct CandTab { int i[64]; int j[64]; int n; };
constexpr CandTab make_cands() {
  CandTab t{};
  int n = 0;
  for (int i = 0; i < 16; ++i)
    for (int j = 0; j < 16; ++j)
      if ((i + 1) * (j + 1) <= 16) { t.i[n] = i; t.j[n] = j; ++n; }
  t.n = n;
  for (int k = n; k < 64; ++k) { t.i[k] = 0; t.j[k] = 0; }
  return t;
}

DI void phase_peer_q(const Params& p, char* smem) {
  const u16* h1b = (const u16*)(p.ws + WS_XB);
  const u16* wt = (const u16*)(p.ws + WS_WQ);
  const u16* keysb = (const u16*)(p.ws + WS_KEYS);
  int* sel_i = (int*)(p.ws + WS_SELI);
  float* sel_g = (float*)(p.ws + WS_SELG);
  float* Sbuf = (float*)smem;
  unsigned* xch = (unsigned*)(smem + 128 * 257 * 4);
  const int tid = threadIdx.x, lane = tid & 63, w = __builtin_amdgcn_readfirstlane(tid >> 6), g = lane >> 4, r16 = lane & 15;
  constexpr int WM = 2;
  const int wm = w % WM, wn = w / WM;
  for (int tile = blockIdx.x, kit = 0; tile < (T / 128) * 8; tile += gridDim.x, ++kit) {
    int mt_, nt_; tile_coords<8>(tile, kit, T / 128, 8, mt_, nt_);
    const int m0 = mt_ * 128, hd = nt_, n0 = hd * 256;
    {
      f32x4 acc[4][4];
      gemm_tile<WM>(h1b, wt, DM, m0, n0, smem, acc);
#pragma unroll
      for (int mi = 0; mi < 4; ++mi)
#pragma unroll
        for (int ni = 0; ni < 4; ++ni)
#pragma unroll
          for (int j = 0; j < 4; ++j) {
            const int row = 64 * wm + 16 * mi + 4 * g + j, col = 64 * wn + 16 * ni + r16;
            *(u16*)(smem + row * 512 + (((col >> 3) ^ (row & 15)) << 4) + (col & 7) * 2) = f2bf(acc[mi][ni][j]);
          }
    }
    __syncthreads();
    f32x4 sc[2][2][4];
    {
      const int swm = w & 3, swn = w >> 2;
#pragma unroll
      for (int pp = 0; pp < 2; ++pp) {
#pragma unroll
        for (int mi = 0; mi < 2; ++mi)
#pragma unroll
          for (int ni = 0; ni < 4; ++ni) sc[pp][mi][ni] = f32x4{0.f, 0.f, 0.f, 0.f};
        bf16x8 bfr[4][4];
#pragma unroll
        for (int kk = 0; kk < 4; ++kk)
#pragma unroll
          for (int ni = 0; ni < 4; ++ni) {
            const int n = 64 * swn + 16 * ni + r16;
            bfr[kk][ni] = *(const bf16x8*)(keysb + ((size_t)(((hd * 2 + pp) * 4 + kk) * 4 + g) * 128 + n) * 8);
          }
#pragma unroll
        for (int kk = 0; kk < 4; ++kk) {
          bf16x8 af[2];
#pragma unroll
          for (int mi = 0; mi < 2; ++mi) {
            const int row = 32 * swm + 16 * mi + r16, c = 16 * pp + 4 * kk + g;
            af[mi] = *(const bf16x8*)(smem + row * 512 + ((c ^ (row & 15)) << 4));
          }
#pragma unroll
          for (int mi = 0; mi < 2; ++mi)
#pragma unroll
            for (int ni = 0; ni < 4; ++ni) sc[pp][mi][ni] = MFMA16(af[mi], bfr[kk][ni], sc[pp][mi][ni]);
        }
      }
      __syncthreads();
#pragma unroll
      for (int pp = 0; pp < 2; ++pp)
#pragma unroll
        for (int mi = 0; mi < 2; ++mi)
#pragma unroll
          for (int ni = 0; ni < 4; ++ni)
#pragma unroll
            for (int j = 0; j < 4; ++j) {
              const int row = 32 * swm + 16 * mi + 4 * g + j, n = 64 * swn + 16 * ni + r16;
              Sbuf[row * 257 + pp * 128 + n] = sc[pp][mi][ni][j];
            }
    }
    __syncthreads();
    unsigned R[16];
    const int tok = tid & 127, half = (tid >> 7) & 1;
    if (tid < 256) {
      const float* srow = Sbuf + tok * 257 + half * 128;
#pragma unroll
      for (int i = 0; i < 16; ++i) R[i] = (enc_key(srow[i]) & ~127u) | (unsigned)(127 - i);
      sort16_desc(R);
#pragma unroll 1
      for (int gi = 1; gi < 8; ++gi) {
        unsigned X[16];
#pragma unroll
        for (int i = 0; i < 16; ++i) X[i] = (enc_key(srow[gi * 16 + i]) & ~127u) | (unsigned)(127 - (gi * 16 + i));
        sort16_desc(X);
        merge16_desc(R, X);
      }
#pragma unroll
      for (int i = 0; i < 16; ++i) xch[(tok * 2 + half) * 16 + i] = R[i];
    }
    __syncthreads();
    if (tid < 128) {
      constexpr CandTab CT = make_cands();
      float s1[16], s2[16];
#pragma unroll
      for (int i = 0; i < 16; ++i) { s1[i] = dec_key(R[i] & ~127u); s2[i] = dec_key(xch[(tok * 2 + 1) * 16 + i] & ~127u); }
      unsigned B[16];
#pragma unroll
      for (int gi = 0; gi < 4; ++gi) {
        unsigned X[16];
#pragma unroll
        for (int i = 0; i < 16; ++i) {
          const int c = gi * 16 + i;
          X[i] = (c < CT.n) ? ((enc_key(s1[CT.i[c]] + s2[CT.j[c]]) & ~255u) | (unsigned)(255 - (CT.i[c] * 16 + CT.j[c]))) : 0u;
        }
        sort16_desc(X);
        if (gi == 0) {
#pragma unroll
          for (int i = 0; i < 16; ++i) B[i] = X[i];
        } else merge16_desc(B, X);
      }
      float e[16], sum = 0.f;
      const float s0 = dec_key(B[0] & ~255u);
#pragma unroll
      for (int i = 0; i < 16; ++i) { e[i] = __expf(dec_key(B[i] & ~255u) - s0); sum += e[i]; }
      const float inv = 1.f / sum;
      int ids[16];
#pragma unroll
      for (int i = 0; i < 16; ++i) {
        const int flat = 255 - (int)(B[i] & 255u);
        const int i1 = 127 - (int)(xch[(tok * 2 + 0) * 16 + (flat >> 4)] & 127u);
        const int i2 = 127 - (int)(xch[(tok * 2 + 1) * 16 + (flat & 15)] & 127u);
        ids[i] = i1 * 128 + i2;
        e[i] *= inv;
      }
      int* di = sel_i + (size_t)(m0 + tok) * 128 + hd * 16;
      float* dg = sel_g + (size_t)(m0 + tok) * 128 + hd * 16;
#pragma unroll
      for (int k = 0; k < 4; ++k) {
        *(int4*)(di + 4 * k) = int4{ids[4 * k], ids[4 * k + 1], ids[4 * k + 2], ids[4 * k + 3]};
        *(float4*)(dg + 4 * k) = float4{e[4 * k], e[4 * k + 1], e[4 * k + 2], e[4 * k + 3]};
      }
    }
    __syncthreads();
  }
}

DI unsigned xcc_id() { return (unsigned)__builtin_amdgcn_s_getreg((3 << 11) | 20) & 0xFu; }
DI unsigned ld_agent(const unsigned* q) { return __hip_atomic_load(q, __ATOMIC_RELAXED, __HIP_MEMORY_SCOPE_AGENT); }

DI void fp8x16_to_f32(const uint4& q, f32x2 (&x)[8]) {
  const unsigned w[4] = {q.x, q.y, q.z, q.w};
#pragma unroll
  for (int k = 0; k < 4; ++k) { x[2 * k] = __builtin_amdgcn_cvt_pk_f32_fp8((int)w[k], false); x[2 * k + 1] = __builtin_amdgcn_cvt_pk_f32_fp8((int)w[k], true); }
}
struct SliceOwner { unsigned mine; int nblk; };
DI SliceOwner read_census(const Params& p, const unsigned my_xcc) {
  const unsigned* census = (const unsigned*)(p.ws + WS_BAR) + 64;
  unsigned cnt[8]; unsigned fallback = 8;
#pragma unroll
  for (int x = 7; x >= 0; --x) { cnt[x] = ld_agent(census + 64 * x); if (cnt[x] > 0) fallback = x; }
  SliceOwner o; o.mine = 0u; o.nblk = 1;
#pragma unroll
  for (int x = 0; x < 8; ++x) {
    const unsigned owner = cnt[x] > 0 ? (unsigned)x : fallback;
    if (owner == my_xcc) o.mine |= 1u << x;
    if ((unsigned)x == my_xcc) o.nblk = (int)cnt[x];
  }
  return o;
}

DI void eu_load(const unsigned char* __restrict__ ub8, const int id0, const int id1, const int cs, const int lane, uint4 (&u)[16]) {
#pragma unroll
  for (int i = 0; i < 16; ++i) {
    const int id = __shfl(i < 8 ? id0 : id1, (8 * i + (lane >> 3)) & 63, 64);
    u[i] = *(const uint4*)(ub8 + (size_t)id * 1024 + 128 * cs + 16 * (lane & 7));
  }
}
DI void eu_compute(const uint4 (&u)[16], const uint4& xq, int* __restrict__ pd, const int lane) {
  int p[16];
#pragma unroll
  for (int i = 0; i < 16; ++i) {
    int acc = __builtin_amdgcn_sdot4((int)u[i].x, (int)xq.x, 0, false);
    acc = __builtin_amdgcn_sdot4((int)u[i].y, (int)xq.y, acc, false);
    acc = __builtin_amdgcn_sdot4((int)u[i].z, (int)xq.z, acc, false);
    p[i] = __builtin_amdgcn_sdot4((int)u[i].w, (int)xq.w, acc, false);
  }
  int q8[8], q4[4], q2[2];
  const bool b2 = lane & 4, b1 = lane & 2, b0 = lane & 1;
#pragma unroll
  for (int j = 0; j < 8; ++j) { const int keep = b2 ? p[8 + j] : p[j], send = b2 ? p[j] : p[8 + j]; q8[j] = keep + __shfl_xor(send, 4, 64); }
#pragma unroll
  for (int j = 0; j < 4; ++j) { const int keep = b1 ? q8[4 + j] : q8[j], send = b1 ? q8[j] : q8[4 + j]; q4[j] = keep + __shfl_xor(send, 2, 64); }
#pragma unroll
  for (int j = 0; j < 2; ++j) { const int keep = b0 ? q4[2 + j] : q4[j], send = b0 ? q4[j] : q4[2 + j]; q2[j] = keep + __shfl_xor(send, 1, 64); }
  const int slot0 = 16 * (lane & 7) + (lane >> 3);
  pd[slot0] = q2[0];
  pd[slot0 + 8] = q2[1];
}
DI void phase_eu(const Params& p, const unsigned my_xcc, const unsigned my_rank) {
  const unsigned char* h1f8 = p.ws + WS_H1F8;
  const unsigned char* ub8 = p.ws + WS_UB;
  const int* sel_i = (const int*)(p.ws + WS_SELI);
  int* pdot = (int*)(p.ws + WS_PDOT);
  const int lane = threadIdx.x & 63, w = __builtin_amdgcn_readfirstlane(threadIdx.x >> 6);
  const SliceOwner so = read_census(p, my_xcc);
#pragma unroll 1
  for (int cs = 0; cs < 8; ++cs) {
    if (!((so.mine >> cs) & 1u)) continue;
    const int nblk = so.nblk;
    int* pd = pdot + (size_t)cs * T * 128;
    if ((int)my_rank >= T / 8) continue;
    const int K = (T / 8 - (int)my_rank + nblk - 1) / nblk;
#define TOK(k) (((int)my_rank + ((k) < K ? (k) : K - 1) * nblk) * 8 + w)
#define EU_IDS(t, i0, i1, xq) do { i0 = sel_i[(size_t)(t) * 128 + lane]; i1 = sel_i[(size_t)(t) * 128 + 64 + lane]; \
                                   xq = *(const uint4*)(h1f8 + (size_t)(t) * 1024 + 128 * cs + 16 * (lane & 7)); } while (0)
    int tA = TOK(0), tB = TOK(1);
    int a0, a1, b0, b1; uint4 xa, xb;
    EU_IDS(tA, a0, a1, xa);
    EU_IDS(tB, b0, b1, xb);
    uint4 uA[16], uB[16];
    eu_load(ub8, a0, a1, cs, lane, uA);
    for (int k = 0; k < K; k += 2) {
      eu_load(ub8, b0, b1, cs, lane, uB);
      const int tA2 = TOK(k + 2); int na0, na1; uint4 nxa;
      EU_IDS(tA2, na0, na1, nxa);
      eu_compute(uA, xa, pd + (size_t)tA * 128, lane);
      eu_load(ub8, na0, na1, cs, lane, uA);
      const int tB2 = TOK(k + 3); int nb0, nb1; uint4 nxb;
      EU_IDS(tB2, nb0, nb1, nxb);
      eu_compute(uB, xb, pd + (size_t)tB * 128, lane);
      tA = tA2; a0 = na0; a1 = na1; xa = nxa; tB = tB2; b0 = nb0; b1 = nb1; xb = nxb;
    }
#undef EU_IDS
  }
}

DI void phase_ec(const Params& p) {
  const int* pdot = (const int*)(p.ws + WS_PDOT);
  const float* sel_g = (const float*)(p.ws + WS_SELG);
  const int* sel_i = (const int*)(p.ws + WS_SELI);
  const float* su = (const float*)(p.ws + WS_SU);
  const float* sx = (const float*)(p.ws + WS_SX);
  float* cbuf = (float*)(p.ws + WS_CBUF);
  const size_t gsz = (size_t)gridDim.x * NT, n = (size_t)T * 128;
  size_t i = (size_t)blockIdx.x * NT + threadIdx.x;
  for (; i + gsz < n; i += 2 * gsz) {
    int d[2] = {0, 0}; int id[2]; float g[2], s2[2];
#pragma unroll
    for (int z = 0; z < 2; ++z) {
      const size_t e = i + z * gsz;
#pragma unroll
      for (int cs = 0; cs < 8; ++cs) d[z] += pdot[(size_t)cs * T * 128 + e];
      id[z] = sel_i[e]; g[z] = sel_g[e]; s2[z] = sx[e >> 7];
    }
#pragma unroll
    for (int z = 0; z < 2; ++z) {
      const float xx = (float)d[z] * su[id[z]] * s2[z];
      const float act = 0.5f * xx * (1.f + erff(xx * 0.70710678118654752f));
      cbuf[i + z * gsz] = act * g[z] * (1.f / V_SCALE);
    }
  }
  for (; i < n; i += gsz) {
    int d = 0;
#pragma unroll
    for (int cs = 0; cs < 8; ++cs) d += pdot[(size_t)cs * T * 128 + i];
    const float xx = (float)d * su[sel_i[i]] * sx[i >> 7];
    const float act = 0.5f * xx * (1.f + erff(xx * 0.70710678118654752f));
    cbuf[i] = act * sel_g[i] * (1.f / V_SCALE);
  }
}

DI void ev_load(const unsigned char* __restrict__ vb8, const int id0, const int id1, const int cs, const int lane, uint4 (&v)[16]) {
#pragma unroll
  for (int i = 0; i < 16; ++i) {
    const int id = __shfl(i < 8 ? id0 : id1, (8 * i + (lane >> 3)) & 63, 64);
    v[i] = *(const uint4*)(vb8 + (size_t)id * 1024 + 128 * cs + 16 * (lane & 7));
  }
}
DI void ev_compute(const uint4 (&v)[16], const float c0, const float c1, u16* __restrict__ yrow, const int lane) {
  f32x2 acc[8];
#pragma unroll
  for (int k = 0; k < 8; ++k) acc[k] = f32x2{0.f, 0.f};
#pragma unroll
  for (int i = 0; i < 16; ++i) {
    const float c = __shfl(i < 8 ? c0 : c1, (8 * i + (lane >> 3)) & 63, 64);
    const f32x2 cc = f32x2{c, c};
    f32x2 vf[8];
    fp8x16_to_f32(v[i], vf);
#pragma unroll
    for (int k = 0; k < 8; ++k) acc[k] = __builtin_elementwise_fma(vf[k], cc, acc[k]);
  }
  float a[16];
#pragma unroll
  for (int k = 0; k < 8; ++k) { a[2 * k] = acc[k][0]; a[2 * k + 1] = acc[k][1]; }
  float q8[8], q4[4], q2[2];
  const bool b5 = lane & 32, b4 = lane & 16, b3 = lane & 8;
#pragma unroll
  for (int j = 0; j < 8; ++j) { const float keep = b5 ? a[8 + j] : a[j], send = b5 ? a[j] : a[8 + j]; q8[j] = keep + __shfl_xor(send, 32, 64); }
#pragma unroll
  for (int j = 0; j < 4; ++j) { const float keep = b4 ? q8[4 + j] : q8[j], send = b4 ? q8[j] : q8[4 + j]; q4[j] = keep + __shfl_xor(send, 16, 64); }
#pragma unroll
  for (int j = 0; j < 2; ++j) { const float keep = b3 ? q4[2 + j] : q4[j], send = b3 ? q4[j] : q4[2 + j]; q2[j] = keep + __shfl_xor(send, 8, 64); }
  *(unsigned*)(yrow + 16 * (lane & 7) + 2 * (lane >> 3)) = pack2(q2[0], q2[1]);
}

DI void phase_ev(const Params& p, const unsigned my_xcc, const unsigned my_rank) {
  const unsigned char* vb8 = p.ws + WS_VB;
  const int* sel_i = (const int*)(p.ws + WS_SELI);
  const float* cbuf = (const float*)(p.ws + WS_CBUF);
  u16* ybuf = (u16*)(p.ws + WS_YBUF);
  const int lane = threadIdx.x & 63, w = __builtin_amdgcn_readfirstlane(threadIdx.x >> 6);
  const SliceOwner so = read_census(p, my_xcc);
#pragma unroll 1
  for (int cs = 0; cs < 8; ++cs) {
    if (!((so.mine >> cs) & 1u)) continue;
    const int nblk = so.nblk;
    if ((int)my_rank >= T / 8) continue;
    const int K = (T / 8 - (int)my_rank + nblk - 1) / nblk;
#define EV_IDS(t, i0, i1, c0, c1) do { i0 = sel_i[(size_t)(t) * 128 + lane]; i1 = sel_i[(size_t)(t) * 128 + 64 + lane]; \
                                       c0 = cbuf[(size_t)(t) * 128 + lane]; c1 = cbuf[(size_t)(t) * 128 + 64 + lane]; } while (0)
    int tA = TOK(0), tB = TOK(1);
    int a0, a1, b0, b1; float ca0, ca1, cb0, cb1;
    EV_IDS(tA, a0, a1, ca0, ca1);
    EV_IDS(tB, b0, b1, cb0, cb1);
    uint4 vA[16], vB[16];
    ev_load(vb8, a0, a1, cs, lane, vA);
    for (int k = 0; k < K; k += 2) {
      ev_load(vb8, b0, b1, cs, lane, vB);
      const int tA2 = TOK(k + 2); int na0, na1; float nca0, nca1;
      EV_IDS(tA2, na0, na1, nca0, nca1);
      ev_compute(vA, ca0, ca1, ybuf + (size_t)tA * 1024 + 128 * cs, lane);
      ev_load(vb8, na0, na1, cs, lane, vA);
      const int tB2 = TOK(k + 3); int nb0, nb1; float ncb0, ncb1;
      EV_IDS(tB2, nb0, nb1, ncb0, ncb1);
      ev_compute(vB, cb0, cb1, ybuf + (size_t)tB * 1024 + 128 * cs, lane);
      tA = tA2; a0 = na0; a1 = na1; ca0 = nca0; ca1 = nca1; tB = tB2; b0 = nb0; b1 = nb1; cb0 = ncb0; cb1 = ncb1;
    }
#undef EV_IDS
#undef TOK
  }
}

DI void phase_ln2(const Params& p) {
  const u16* ybuf = (const u16*)(p.ws + WS_YBUF);
  const u16* h1b = (const u16*)(p.ws + WS_XB);
  const int lane = threadIdx.x & 63, w = __builtin_amdgcn_readfirstlane(threadIdx.x >> 6);
  float4 gg[4], bb[4];
#pragma unroll
  for (int k = 0; k < 4; ++k) { gg[k] = *(const float4*)(p.ln2_g + 256 * k + 4 * lane); bb[k] = *(const float4*)(p.ln2_b + 256 * k + 4 * lane); }
  for (int tb = blockIdx.x; tb < T / 8; tb += 2 * gridDim.x) {
    const int tb1 = tb + (int)gridDim.x < T / 8 ? tb + (int)gridDim.x : tb;
    const int tt[2] = {tb * 8 + w, tb1 * 8 + w};
    float4 v[2][4];
#pragma unroll
    for (int z = 0; z < 2; ++z)
#pragma unroll
      for (int k = 0; k < 4; ++k) {
        const uint2 hq = *(const uint2*)(h1b + (size_t)tt[z] * 1024 + 256 * k + 4 * lane);
        const uint2 yq = *(const uint2*)(ybuf + (size_t)tt[z] * 1024 + 256 * k + 4 * lane);
        const float4 y = float4{bflo(yq.x), bfhi(yq.x), bflo(yq.y), bfhi(yq.y)};
        v[z][k] = float4{ALPHA * bflo(hq.x) + y.x, ALPHA * bfhi(hq.x) + y.y, ALPHA * bflo(hq.y) + y.z, ALPHA * bfhi(hq.y) + y.w};
      }
#pragma unroll
    for (int z = 0; z < 2; ++z) {
      float sm = 0.f;
#pragma unroll
      for (int k = 0; k < 4; ++k) sm += v[z][k].x + v[z][k].y + v[z][k].z + v[z][k].w;
      const float mean = wave_sum(sm) * (1.f / 1024.f);
      float sq = 0.f;
#pragma unroll
      for (int k = 0; k < 4; ++k) { float d; d = v[z][k].x - mean; sq += d * d; d = v[z][k].y - mean; sq += d * d; d = v[z][k].z - mean; sq += d * d; d = v[z][k].w - mean; sq += d * d; }
      const float rstd = rsqrtf(wave_sum(sq) * (1.f / 1024.f) + LN_EPS);
#pragma unroll
      for (int k = 0; k < 4; ++k) {
        float4 o;
        o.x = (v[z][k].x - mean) * rstd * gg[k].x + bb[k].x; o.y = (v[z][k].y - mean) * rstd * gg[k].y + bb[k].y;
        o.z = (v[z][k].z - mean) * rstd * gg[k].z + bb[k].z; o.w = (v[z][k].w - mean) * rstd * gg[k].w + bb[k].w;
        *(float4*)(p.out + (size_t)tt[z] * 1024 + 256 * k + 4 * lane) = o;
      }
    }
  }
}

DI void grid_barrier(unsigned* ctr, unsigned target) {
  asm volatile("s_waitcnt vmcnt(0)" ::: "memory");
  __syncthreads();
  if (threadIdx.x == 0) {
    __builtin_amdgcn_fence(__ATOMIC_RELEASE, "agent");
    asm volatile("s_waitcnt vmcnt(0)" ::: "memory");
    (void)__hip_atomic_fetch_add(ctr, 1u, __ATOMIC_RELAXED, __HIP_MEMORY_SCOPE_AGENT);
    unsigned spins = 0;
    while (__hip_atomic_load(ctr, __ATOMIC_RELAXED, __HIP_MEMORY_SCOPE_AGENT) < target) {
      __builtin_amdgcn_s_sleep(1);
      if (++spins > (1u << 24)) break;
    }
    __builtin_amdgcn_fence(__ATOMIC_ACQUIRE, "agent");
    asm volatile("s_waitcnt vmcnt(0)" ::: "memory");
  }
  __syncthreads();
}

DI void grid_barrier_xcd(unsigned* bar, const unsigned gen, const unsigned my_xcc, const unsigned n_local, const unsigned n_xcds) {
  asm volatile("s_waitcnt vmcnt(0)" ::: "memory");
  __syncthreads();
  if (threadIdx.x == 0) {
    unsigned* xcnt = bar + 768 + 32 * my_xcc;
    unsigned* top = bar + 640;
    unsigned* rel = bar + 704;
    const unsigned old = __hip_atomic_fetch_add(xcnt, 1u, __ATOMIC_RELAXED, __HIP_MEMORY_SCOPE_AGENT);
    unsigned* xrel = bar + 96 + 64 * my_xcc;
    unsigned spins = 0;
    if (old + 1u == gen * n_local) {
      __builtin_amdgcn_fence(__ATOMIC_RELEASE, "agent");
      asm volatile("s_waitcnt vmcnt(0)" ::: "memory");
      const unsigned t = __hip_atomic_fetch_add(top, 1u, __ATOMIC_RELAXED, __HIP_MEMORY_SCOPE_AGENT);
      if (t + 1u == gen * n_xcds) __hip_atomic_store(rel, gen, __ATOMIC_RELAXED, __HIP_MEMORY_SCOPE_AGENT);
      while (__hip_atomic_load(rel, __ATOMIC_RELAXED, __HIP_MEMORY_SCOPE_AGENT) < gen) {
        __builtin_amdgcn_s_sleep(1);
        if (++spins > (1u << 24)) break;
      }
      __hip_atomic_store(xrel, gen, __ATOMIC_RELAXED, __HIP_MEMORY_SCOPE_AGENT);
    } else {
      while (__hip_atomic_load(xrel, __ATOMIC_RELAXED, __HIP_MEMORY_SCOPE_AGENT) < gen) {
        __builtin_amdgcn_s_sleep(1);
        if (++spins > (1u << 24)) break;
      }
    }
    __builtin_amdgcn_fence(__ATOMIC_ACQUIRE, "agent");
    asm volatile("s_waitcnt vmcnt(0)" ::: "memory");
  }
  __syncthreads();
}

__global__ void __launch_bounds__(NT) hymba_fwd(Params p) {
  extern __shared__ __attribute__((aligned(16))) char smem[];
  const int lo = p.ph_lo, hi = p.ph_hi;
  const unsigned my_xcc = xcc_id() & 7u;
  unsigned my_rank = 0;
  if (threadIdx.x == 0) {
    my_rank = __hip_atomic_fetch_add((unsigned*)(p.ws + WS_BAR) + 64 + 64 * my_xcc, 1u, __ATOMIC_RELAXED, __HIP_MEMORY_SCOPE_AGENT);
    (void)__hip_atomic_fetch_add((unsigned*)(p.ws + WS_BAR) + 576, 1u, __ATOMIC_RELAXED, __HIP_MEMORY_SCOPE_AGENT);
  }
  if (threadIdx.x == 0) *(unsigned*)smem = my_rank;
  __syncthreads();
  my_rank = *(const unsigned*)smem;
  __syncthreads();
#define IN(k) (lo <= (k) && (k) < hi)
  unsigned bar_target = 0;
  unsigned xgen = 0, n_local = 0, n_xcds = 0;
#define SEAM(k) do { if (IN(k) && IN((k) + 1)) { \
    if (n_local == 0) { \
      if (threadIdx.x == 0) { unsigned sp_ = 0; while (ld_agent((const unsigned*)(p.ws + WS_BAR) + 576) < gridDim.x) { __builtin_amdgcn_s_sleep(1); if (++sp_ > (1u << 24)) break; } } \
      __syncthreads(); \
      _Pragma("unroll") for (int x_ = 0; x_ < 8; ++x_) { const unsigned c_ = ld_agent((const unsigned*)(p.ws + WS_BAR) + 64 + 64 * x_); n_xcds += c_ > 0; if ((unsigned)x_ == my_xcc) n_local = c_; } \
    } \
    ++xgen; grid_barrier_xcd((unsigned*)(p.ws + WS_BAR), xgen, my_xcc, n_local, n_xcds); } } while (0)
  if (IN(0)) {
    const size_t gtid = (size_t)blockIdx.x * NT + threadIdx.x, gsz = (size_t)gridDim.x * NT;
    cvt_linear(p.x, (u16*)(p.ws + WS_XB), (size_t)T * DM / 8, gtid, gsz);
    {
      u16* kd = (u16*)(p.ws + WS_KEYS);
      for (size_t i = gtid; i < (size_t)8 * 2 * 128 * 16; i += gsz) {
        const int c8 = (int)(i & 15), n = (int)((i >> 4) & 127), hp = (int)(i >> 11);
        const float4 a = *(const float4*)(p.keys + i * 8), b = *(const float4*)(p.keys + i * 8 + 4);
        *(uint4*)(kd + ((size_t)((hp * 4 + (c8 >> 2)) * 4 + (c8 & 3)) * 128 + n) * 8) = cvt8(a, b);
      }
    }
    cvt_transpose(p.w_in, (u16*)(p.ws + WS_WIN), DM, NPROJ, gtid, gsz);
  }
  SEAM(0);
  if (IN(1)) phase_inproj(p, smem);
  SEAM(1);
  if (IN(2)) { phase_attn(p, smem); phase_conv(p, smem); }
  SEAM(2);
  if (IN(3)) phase_outproj(p, smem);
  SEAM(3);
  if (IN(4)) phase_ln1(p);
  SEAM(4);
  if (IN(5)) phase_peer_q(p, smem);
  SEAM(5);
  if (IN(6)) phase_eu(p, my_xcc, my_rank);
  SEAM(6);
  if (IN(7)) phase_ec(p);
  SEAM(7);
  if (IN(8)) phase_ev(p, my_xcc, my_rank);
  SEAM(8);
  if (IN(9)) phase_ln2(p);
#undef IN
#undef SEAM
}

extern "C" void kernel_launch(void* const* d_in, const int* in_sizes, int n_in, void* d_out, int out_size, void* d_ws, size_t ws_size, hipStream_t stream) {
  static int grid = 0;
  if (grid == 0) {
    int dev = 0, cus = 0, per_cu = 0;
    hipGetDevice(&dev);
    hipDeviceGetAttribute(&cus, hipDeviceAttributeMultiprocessorCount, dev);
    hipFuncSetAttribute((const void*)hymba_fwd, hipFuncAttributeMaxDynamicSharedMemorySize, LDS_BYTES);
    if (hipOccupancyMaxActiveBlocksPerMultiprocessor(&per_cu, (const void*)hymba_fwd, NT, LDS_BYTES) != hipSuccess || per_cu < 1) {
      fprintf(stderr, "kernel_launch: occupancy query gave %d blocks per CU\n", per_cu); per_cu = 1;
    }
    (void)hipGetLastError();
    if (per_cu > 1) per_cu = 1;
    grid = cus * per_cu;
    if (ws_size < WS_END) fprintf(stderr, "kernel_launch: workspace too small: %zu < %zu\n", ws_size, (size_t)WS_END);
  }
  Params p{};
  p.x = (const float*)d_in[0]; p.w_in = (const float*)d_in[1]; p.b_in = (const float*)d_in[2]; p.conv_w = (const float*)d_in[3];
  p.conv_b = (const float*)d_in[4]; p.cln_g = (const float*)d_in[5]; p.cln_b = (const float*)d_in[6]; p.w_out = (const float*)d_in[7];
  p.b_out = (const float*)d_in[8]; p.ln1_g = (const float*)d_in[9]; p.ln1_b = (const float*)d_in[10]; p.wq = (const float*)d_in[11];
  p.keys = (const float*)d_in[12]; p.ut = (const float*)d_in[13]; p.vt = (const float*)d_in[14]; p.ln2_g = (const float*)d_in[15];
  p.ln2_b = (const float*)d_in[16];
  p.out = (float*)d_out; p.ws = (unsigned char*)d_ws;
  p.ph_lo = 0; p.ph_hi = 10;
  (void)hipMemsetAsync((unsigned char*)d_ws + WS_BAR, 0, 4096, stream);
  hipLaunchKernelGGL(hymba_fwd, dim3(grid), dim3(NT), LDS_BYTES, stream, p);
}
```

```cpp
#include <hip/hip_runtime.h>
#include <cstdio>

typedef __attribute__((ext_vector_type(8))) short bf16x8;
typedef __attribute__((ext_vector_type(4))) float f32x4;
typedef unsigned short u16;
#define DI __device__ __forceinline__
#define MFMA16(a, b, c) __builtin_amdgcn_mfma_f32_16x16x32_bf16((a), (b), (c), 0, 0, 0)


constexpr int NT = 512;
constexpr int T = 32768;
constexpr int SEQ = 2048;
constexpr int DM = 1024;
constexpr int NPROJ = 2560;
constexpr float ALPHA = 1.189207115002721f;
constexpr float LN_EPS = 1e-5f;
constexpr float LOG2E = 1.4426950408889634f;
constexpr float V_SCALE = 8.f;

constexpr size_t MB = 1024 * 1024;
constexpr size_t WS_XB = 0;
constexpr size_t WS_WIN = WS_XB + 64 * MB;
constexpr size_t WS_WOUT = WS_WIN + 5 * MB;
constexpr size_t WS_WQ = WS_WOUT + 2 * MB;
constexpr size_t WS_KEYS = WS_WQ + 4 * MB;
constexpr size_t WS_UB = WS_KEYS + 1 * MB;
constexpr size_t WS_VB = WS_UB + 32 * MB;
constexpr size_t WS_PU = WS_VB + 32 * MB;
constexpr size_t WS_Q = WS_PU + 64 * MB;
constexpr size_t WS_K = WS_Q + 32 * MB;
constexpr size_t WS_VT = WS_K + 32 * MB;
constexpr size_t WS_VT4 = WS_VT + 32 * MB;
constexpr size_t WS_VT16 = WS_VT4 + 32 * MB;
constexpr size_t WS_K4 = WS_VT16 + 32 * MB;
constexpr size_t WS_MIX = WS_K4 + 32 * MB;
constexpr size_t WS_H1F8 = WS_MIX;
constexpr size_t WS_CBUF = WS_MIX + 32 * MB;
constexpr size_t WS_PDOT = WS_PU;
constexpr size_t WS_YBUF = WS_PU;
constexpr size_t WS_SELI = WS_MIX + 64 * MB;
constexpr size_t WS_SELG = WS_SELI + 16 * MB;
constexpr size_t WS_K16 = WS_SELI;
constexpr size_t WS_BAR = WS_SELG + 16 * MB;
constexpr size_t WS_SU = WS_BAR + 4096;
constexpr size_t WS_SX = WS_SU + 65536;
constexpr size_t WS_END = WS_SX + 131072;

constexpr int LDS_BYTES = 128 * 257 * 4 + 128 * 2 * 16 * 4;

struct Params {
  const float* x; const float* w_in; const float* b_in; const float* conv_w; const float* conv_b; const float* cln_g; const float* cln_b;
  const float* w_out; const float* b_out; const float* ln1_g; const float* ln1_b; const float* wq; const float* keys; const float* ut; const float* vt;
  const float* ln2_g; const float* ln2_b;
  float* out; unsigned char* ws;
  int ph_lo, ph_hi;
};

typedef float f32x2 __attribute__((ext_vector_type(2)));
typedef __bf16 bf16x2_t __attribute__((ext_vector_type(2)));
DI unsigned pack2(float a, float b) { const f32x2 v = {a, b}; const bf16x2_t r = __builtin_convertvector(v, bf16x2_t); return __builtin_bit_cast(unsigned, r); }
DI u16 f2bf(float x) { return (u16)(pack2(x, x) & 0xffffu); }
DI float bf2f(u16 h) { return __uint_as_float(((unsigned)h) << 16); }
DI float bflo(unsigned w) { return __uint_as_float(w << 16); }
DI float bfhi(unsigned w) { return __uint_as_float(w & 0xffff0000u); }
DI float wave_sum(float v) {
#pragma unroll
  for (int o = 32; o > 0; o >>= 1) v += __shfl_xor(v, o, 64);
  return v;
}
DI uint4 cvt8(const float4 a, const float4 b) { uint4 r; r.x = pack2(a.x, a.y); r.y = pack2(a.z, a.w); r.z = pack2(b.x, b.y); r.w = pack2(b.z, b.w); return r; }

DI void cvt_linear(const float* __restrict__ src, u16* __restrict__ dst, size_t n8, size_t gtid, size_t gsz) {
  for (size_t i = gtid; i < n8; i += gsz) {
    const float4 a = *(const float4*)(src + i * 8), b = *(const float4*)(src + i * 8 + 4);
    *(uint4*)(dst + i * 8) = cvt8(a, b);
  }
}
DI unsigned pk4_fp8(float a, float b, float c, float d) {
  int r = 0;
  r = __builtin_amdgcn_cvt_pk_fp8_f32(a, b, r, false);
  r = __builtin_amdgcn_cvt_pk_fp8_f32(c, d, r, true);
  return (unsigned)r;
}
DI void cvt_linear_fp8(const float* __restrict__ src, unsigned char* __restrict__ dst, size_t n16, float scale, size_t gtid, size_t gsz) {
  for (size_t i = gtid; i < n16; i += gsz) {
    const float4 a = *(const float4*)(src + i * 16), b = *(const float4*)(src + i * 16 + 4), c = *(const float4*)(src + i * 16 + 8), d = *(const float4*)(src + i * 16 + 12);
    uint4 r;
    r.x = pk4_fp8(a.x * scale, a.y * scale, a.z * scale, a.w * scale); r.y = pk4_fp8(b.x * scale, b.y * scale, b.z * scale, b.w * scale);
    r.z = pk4_fp8(c.x * scale, c.y * scale, c.z * scale, c.w * scale); r.w = pk4_fp8(d.x * scale, d.y * scale, d.z * scale, d.w * scale);
    *(uint4*)(dst + i * 16) = r;
  }
}
DI unsigned pk4_i8(float a, float b, float c, float d) {
  const int ia = (int)rintf(a), ib = (int)rintf(b), ic = (int)rintf(c), id = (int)rintf(d);
  return (unsigned)(ia & 255) | ((unsigned)(ib & 255) << 8) | ((unsigned)(ic & 255) << 16) | ((unsigned)(id & 255) << 24);
}
DI void cvt_rows_i8(const float* __restrict__ src, unsigned char* __restrict__ dst, float* __restrict__ scale_out, size_t n16, size_t gtid, size_t gsz) {
  for (size_t i = gtid; i < n16; i += gsz) {
    const float4 a = *(const float4*)(src + i * 16), b = *(const float4*)(src + i * 16 + 4), c = *(const float4*)(src + i * 16 + 8), d = *(const float4*)(src + i * 16 + 12);
    float m = fmaxf(fmaxf(fmaxf(fabsf(a.x), fabsf(a.y)), fmaxf(fabsf(a.z), fabsf(a.w))), fmaxf(fmaxf(fabsf(b.x), fabsf(b.y)), fmaxf(fabsf(b.z), fabsf(b.w))));
    m = fmaxf(m, fmaxf(fmaxf(fmaxf(fabsf(c.x), fabsf(c.y)), fmaxf(fabsf(c.z), fabsf(c.w))), fmaxf(fmaxf(fabsf(d.x), fabsf(d.y)), fmaxf(fabsf(d.z), fabsf(d.w)))));
#pragma unroll
    for (int o = 32; o > 0; o >>= 1) m = fmaxf(m, __shfl_xor(m, o, 64));
    m = fmaxf(m, 1e-30f);
    const float q = 127.f / m;
    uint4 r;
    r.x = pk4_i8(a.x * q, a.y * q, a.z * q, a.w * q); r.y = pk4_i8(b.x * q, b.y * q, b.z * q, b.w * q);
    r.z = pk4_i8(c.x * q, c.y * q, c.z * q, c.w * q); r.w = pk4_i8(d.x * q, d.y * q, d.z * q, d.w * q);
    *(uint4*)(dst + i * 16) = r;
    if ((i & 63) == 0) scale_out[i >> 6] = m * (1.f / 127.f);
  }
}
DI void cvt_transpose(const float* __restrict__ src, u16* __restrict__ dst, int K, int N, size_t gtid, size_t gsz) {
  const size_t total = (size_t)N * (K / 8);
  for (size_t i = gtid; i < total; i += gsz) {
    const int n = (int)(i % N), k8 = (int)(i / N);
    float v[8];
#pragma unroll
    for (int j = 0; j < 8; ++j) v[j] = src[(size_t)(k8 * 8 + j) * N + n];
    uint4 r; r.x = pack2(v[0], v[1]); r.y = pack2(v[2], v[3]); r.z = pack2(v[4], v[5]); r.w = pack2(v[6], v[7]);
    *(uint4*)(dst + (size_t)n * K + k8 * 8) = r;
  }
}

constexpr int STAGE_BYTES = 384 * 128;

typedef __attribute__((address_space(3))) unsigned lds_u32;
template <int WM>
DI void gemm_tile(const u16* __restrict__ A, const u16* __restrict__ Bt, const int K, const int m0, const int n0, char* smem, f32x4 (&acc)[4][4]) {
  constexpr int BM = 64 * WM;
  const int tid = threadIdx.x, lane = tid & 63, w = __builtin_amdgcn_readfirstlane(tid >> 6);
  const int wm = w % WM, wn = w / WM;
  const int g = lane >> 4, r16 = lane & 15;
#pragma unroll
  for (int i = 0; i < 4; ++i)
#pragma unroll
    for (int j = 0; j < 4; ++j) acc[i][j] = f32x4{0.f, 0.f, 0.f, 0.f};
  const int srow = tid >> 3, sc = tid & 7;
  const u16* gp[6];
#pragma unroll
  for (int i = 0; i < 6; ++i) {
    const int row = srow + 64 * i;
    const int c = sc ^ ((row >> 1) & 7);
    gp[i] = (i < WM) ? (A + (size_t)(m0 + row) * K + c * 8) : (Bt + (size_t)(n0 + row - BM) * K + c * 8);
  }
  lds_u32* lbase = (lds_u32*)(smem + tid * 16);
#define STAGE(KOFF, BUF) do { \
    _Pragma("unroll") for (int i = 0; i < 6; ++i) \
      __builtin_amdgcn_global_load_lds((const unsigned*)(gp[i] + (KOFF)), (lds_u32*)((__attribute__((address_space(3))) char*)lbase + (BUF) * STAGE_BYTES + i * 8192), 16, 0, 0); } while (0)
  const int KT = K / 64;
  STAGE(0, 0);
  STAGE(64, 1);
  for (int kt = 0; kt < KT; ++kt) {
    asm volatile("s_waitcnt vmcnt(6)" ::: "memory");
    __builtin_amdgcn_s_barrier();
    const int kn = (kt + 2 < KT ? kt + 2 : KT - 1) * 64;
    const int bn = (kt + 2) % 3, bc = kt % 3;
    STAGE(kn, bn);
    const char* cur = smem + bc * STAGE_BYTES;
    bf16x8 af[2][4], bfr[2][4];
#pragma unroll
    for (int kk = 0; kk < 2; ++kk) {
      const int c = 4 * kk + g;
#pragma unroll
      for (int mi = 0; mi < 4; ++mi) { const int row = 64 * wm + 16 * mi + r16; af[kk][mi] = *(const bf16x8*)(cur + row * 128 + ((c ^ ((row >> 1) & 7)) << 4)); }
#pragma unroll
      for (int ni = 0; ni < 4; ++ni) { const int row = BM + 64 * wn + 16 * ni + r16; bfr[kk][ni] = *(const bf16x8*)(cur + row * 128 + ((c ^ ((row >> 1) & 7)) << 4)); }
    }
#pragma unroll
    for (int kk = 0; kk < 2; ++kk)
#pragma unroll
      for (int mi = 0; mi < 4; ++mi)
#pragma unroll
        for (int ni = 0; ni < 4; ++ni) acc[mi][ni] = MFMA16(af[kk][mi], bfr[kk][ni], acc[mi][ni]);
  }
#undef STAGE
  asm volatile("s_waitcnt vmcnt(0)" ::: "memory");
  __syncthreads();
}

template <int MMG>
DI void tile_coords(const int lin, const int k, const int MT, const int NTN, int& mt, int& nt) {
  const int G = gridDim.x, total = MT * NTN;
  if ((G & 7) == 0 && total % G == 0 && (MT & 7) == 0 && ((MT >> 3) % MMG) == 0) {
    const int x = blockIdx.x & 7, r = blockIdx.x >> 3, q = r + (G >> 3) * k;
    const int mm = q % MMG, rest = q / MMG;
    nt = rest % NTN;
    mt = x * (MT >> 3) + (rest / NTN) * MMG + mm;
  } else { mt = lin / NTN; nt = lin % NTN; }
}

constexpr int CT_PITCH = 132;
DI void stage_acc(const f32x4 (&acc)[4][4], char* smem, const int wm, const int wn, const int g, const int r16) {
  float* ct = (float*)smem;
#pragma unroll
  for (int mi = 0; mi < 4; ++mi)
#pragma unroll
    for (int ni = 0; ni < 4; ++ni)
#pragma unroll
      for (int j = 0; j < 4; ++j) ct[(64 * wm + 16 * mi + 4 * g + j) * CT_PITCH + 64 * wn + 16 * ni + r16] = acc[mi][ni][j];
}

constexpr int BIG_STAGE = 512 * 128;
DI void gemm_tile_big(const u16* __restrict__ A, const u16* __restrict__ Bt, const int K, const int m0, const int n0, char* smem, f32x4 (&acc)[8][4]) {
  const int tid = threadIdx.x, lane = tid & 63, w = __builtin_amdgcn_readfirstlane(tid >> 6);
  const int wm = w & 1, wn = w >> 1;
  const int g = lane >> 4, r16 = lane & 15;
#pragma unroll
  for (int i = 0; i < 8; ++i)
#pragma unroll
    for (int j = 0; j < 4; ++j) acc[i][j] = f32x4{0.f, 0.f, 0.f, 0.f};
  const int srow = tid >> 3, sc = tid & 7;
  const int c = sc ^ ((srow >> 1) & 7);
  const u16* ga = A + (size_t)(m0 + srow) * K + c * 8;
  const u16* gb = Bt + (size_t)(n0 + srow) * K + c * 8;
  const size_t rs = (size_t)64 * K;
  __attribute__((address_space(3))) char* lbase = (__attribute__((address_space(3))) char*)(smem + tid * 16);
#define STAGEB(KOFF, BUF) do { \
    _Pragma("unroll") for (int i = 0; i < 4; ++i) { \
      __builtin_amdgcn_global_load_lds((const unsigned*)(ga + i * rs + (KOFF)), (lds_u32*)(lbase + (BUF) * BIG_STAGE + i * 8192), 16, 0, 0); \
      __builtin_amdgcn_global_load_lds((const unsigned*)(gb + i * rs + (KOFF)), (lds_u32*)(lbase + (BUF) * BIG_STAGE + 32768 + i * 8192), 16, 0, 0); } } while (0)
  const int KT = K / 64;
  STAGEB(0, 0);
  asm volatile("s_waitcnt vmcnt(0)" ::: "memory");
  __builtin_amdgcn_s_barrier();
#pragma unroll 1
  for (int kt = 0; kt < KT; ++kt) {
    STAGEB((kt + 1 < KT ? kt + 1 : kt) * 64, (kt + 1) & 1);
    const char* cur = smem + (kt & 1) * BIG_STAGE;
#pragma unroll
    for (int kk = 0; kk < 2; ++kk) {
      const int cc = 4 * kk + g;
      bf16x8 bfr[4];
#pragma unroll
      for (int ni = 0; ni < 4; ++ni) { const int row = 256 + 64 * wn + 16 * ni + r16; bfr[ni] = *(const bf16x8*)(cur + row * 128 + ((cc ^ ((row >> 1) & 7)) << 4)); }
#pragma unroll
      for (int mi = 0; mi < 8; ++mi) {
        const int row = 128 * wm + 16 * mi + r16;
        const bf16x8 af = *(const bf16x8*)(cur + row * 128 + ((cc ^ ((row >> 1) & 7)) << 4));
#pragma unroll
        for (int ni = 0; ni < 4; ++ni) acc[mi][ni] = MFMA16(af, bfr[ni], acc[mi][ni]);
      }
    }
    asm volatile("s_waitcnt vmcnt(0)" ::: "memory");
    __builtin_amdgcn_s_barrier();
  }
#undef STAGEB
}
template <int HF>
DI void stage_acc_big(const f32x4 (&acc)[8][4], char* smem, const int g, const int r16) {
  const int w = __builtin_amdgcn_readfirstlane(threadIdx.x >> 6), wm = w & 1, wn = w >> 1;
  if ((wn >> 1) != HF) return;
  float* ct = (float*)smem;
#pragma unroll
  for (int mi = 0; mi < 8; ++mi)
#pragma unroll
    for (int ni = 0; ni < 4; ++ni)
#pragma unroll
      for (int j = 0; j < 4; ++j) ct[(128 * wm + 16 * mi + 4 * g + j) * CT_PITCH + 64 * (wn & 1) + 16 * ni + r16] = acc[mi][ni][j];
}

template <int D> DI size_t attn_kidx(int bh, int s, int d) {
  const int r = s % D, l = s / D;
  return ((size_t)((bh * D + r) * (128 / D) + (l >> 4)) * 8 + (d >> 3)) * 128 + (l & 15) * 8 + (d & 7);
}
template <int D> DI size_t attn_vidx(int bh, int s, int d) {
  const int r = s % D, l = s / D;
  return ((size_t)((bh * D + r) * (128 / D) + (l >> 4)) * 64 + d) * 16 + (l & 15);
}

DI void inproj_epilogue(const Params& p, const char* smem, const int m0, const int n0) {
  u16* pu = (u16*)(p.ws + WS_PU); u16* qb = (u16*)(p.ws + WS_Q); u16* kb = (u16*)(p.ws + WS_K); u16* vT = (u16*)(p.ws + WS_VT);
  u16* vT4 = (u16*)(p.ws + WS_VT4); u16* vT16 = (u16*)(p.ws + WS_VT16); u16* k4 = (u16*)(p.ws + WS_K4); u16* k16 = (u16*)(p.ws + WS_K16);
  const float* ct = (const float*)smem;
  if (n0 < 1536) {
    u16* dst = n0 < 1024 ? (pu + (size_t)m0 * 1024 + n0) : (qb + (size_t)m0 * 512 + (n0 - 1024));
    const int ld = n0 < 1024 ? 1024 : 512;
#pragma unroll 4
    for (int i = 0; i < 16; ++i) {
      const int c = threadIdx.x + NT * i, row = c >> 5, ch = c & 31;
      const float4 y = *(const float4*)(ct + row * CT_PITCH + 4 * ch), bv = *(const float4*)(p.b_in + n0 + 4 * ch);
      uint2 r; r.x = pack2(y.x + bv.x, y.y + bv.y); r.y = pack2(y.z + bv.z, y.w + bv.w);
      *(uint2*)(dst + (size_t)row * ld + 4 * ch) = r;
    }
    return;
  }
  const int bbase = (m0 >> 11) * 8, s0 = m0 & 2047;
  if (n0 < 2048) {
    const int cc0 = n0 - 1536;
#pragma unroll 2
    for (int i = 0; i < 8; ++i) {
      const int q = threadIdx.x + NT * i, row = q >> 4, ch16 = q & 15;
      const float4 y0 = *(const float4*)(ct + row * CT_PITCH + 8 * ch16), y1 = *(const float4*)(ct + row * CT_PITCH + 8 * ch16 + 4);
      const float4 b0 = *(const float4*)(p.b_in + n0 + 8 * ch16), b1 = *(const float4*)(p.b_in + n0 + 8 * ch16 + 4);
      uint4 r; r.x = pack2(y0.x + b0.x, y0.y + b0.y); r.y = pack2(y0.z + b0.z, y0.w + b0.w); r.z = pack2(y1.x + b1.x, y1.y + b1.y); r.w = pack2(y1.z + b1.z, y1.w + b1.w);
      const int cc = cc0 + 8 * ch16, bh = bbase + (cc >> 6), d = cc & 63, s = s0 + row;
      *(uint4*)(kb + attn_kidx<1>(bh, s, d)) = r;
      *(uint4*)(k4 + attn_kidx<4>(bh, s, d)) = r;
      *(uint4*)(k16 + attn_kidx<16>(bh, s, d)) = r;
    }
  } else {
    const int cc0 = n0 - 2048;
#pragma unroll 2
    for (int i = 0; i < 8; ++i) {
      const int q = threadIdx.x + NT * i, col = q & 127, cidx = q >> 7;
      const float bias = p.b_in[n0 + col];
      const int cc = cc0 + col, bh = bbase + (cc >> 6), d = cc & 63;
#define V_CHUNK(D, DST) do { \
        const int r_ = cidx % (D), l8_ = (cidx / (D)) * 8; \
        float e_[8]; \
        _Pragma("unroll") for (int j = 0; j < 8; ++j) e_[j] = ct[((D) * (l8_ + j) + r_) * CT_PITCH + col] + bias; \
        uint4 w_; w_.x = pack2(e_[0], e_[1]); w_.y = pack2(e_[2], e_[3]); w_.z = pack2(e_[4], e_[5]); w_.w = pack2(e_[6], e_[7]); \
        *(uint4*)((DST) + attn_vidx<D>(bh, s0 + (D) * l8_ + r_, d)) = w_; } while (0)
      V_CHUNK(1, vT);
      V_CHUNK(4, vT4);
      V_CHUNK(16, vT16);
#undef V_CHUNK
    }
  }
}

DI void phase_inproj(const Params& p, char* smem) {
  const u16* xb = (const u16*)(p.ws + WS_XB);
  const u16* wt = (const u16*)(p.ws + WS_WIN);
  const int lane = threadIdx.x & 63, g = lane >> 4, r16 = lane & 15;
  const int NTN = NPROJ / 256;
  for (int tile = blockIdx.x, kit = 0; tile < (T / 256) * NTN; tile += gridDim.x, ++kit) {
    int mt_, nt_; tile_coords<4>(tile, kit, T / 256, NTN, mt_, nt_);
    const int m0 = mt_ * 256, n0 = nt_ * 256;
    {
      const size_t vt_ = (size_t)tile * NT + threadIdx.x, vsz_ = (size_t)(T / 256) * NTN * NT;
      cvt_transpose(p.w_out, (u16*)(p.ws + WS_WOUT), DM, DM, vt_, vsz_);
      cvt_transpose(p.wq, (u16*)(p.ws + WS_WQ), DM, 2048, vt_, vsz_);
    }
    f32x4 acc[8][4];
    gemm_tile_big(xb, wt, DM, m0, n0, smem, acc);
    stage_acc_big<0>(acc, smem, g, r16);
    __syncthreads();
    inproj_epilogue(p, smem, m0, n0);
    __syncthreads();
    stage_acc_big<1>(acc, smem, g, r16);
    __syncthreads();
    inproj_epilogue(p, smem, m0, n0 + 128);
    __syncthreads();
  }
}

template <int D>
DI void attn_task2(const u16* __restrict__ qb, const u16* __restrict__ kd, const u16* __restrict__ vTd, const int b, const int h,
                   const int rA, const int l0A, const int rB, const int l0B, const float c2, f32x4 (&O)[2][4], float (&m_out)[2], float (&l_out)[2]) {
  const int lane = threadIdx.x & 63, g = lane >> 4, i16 = lane & 15;
  const float c1 = 0.125f * LOG2E;
  const float c2d = c2 * (float)D;
  int nsteps = (l0A + 16 + 31) >> 5;
  nsteps = nsteps > 5 ? 5 : nsteps;
  int l0[2] = {l0A, l0B}, lq[2], first[2], bhr[2];
  bf16x8 qf[2][2];
  float m[2] = {-1e30f, -1e30f}, l[2] = {0.f, 0.f};
#pragma unroll
  for (int z = 0; z < 2; ++z) {
    const int r = z ? rB : rA;
    lq[z] = l0[z] + i16;
    const int tq = D * lq[z] + r;
#pragma unroll
    for (int kk = 0; kk < 2; ++kk) qf[z][kk] = *(const bf16x8*)(qb + (size_t)(b * SEQ + tq) * 512 + h * 64 + 8 * g + 32 * kk);
#pragma unroll
    for (int c = 0; c < 4; ++c) O[z][c] = f32x4{0.f, 0.f, 0.f, 0.f};
    first[z] = l0[z] + 16 - 32 * nsteps;
    bhr[z] = ((b * 8 + h) * D + r) * (128 / D);
  }
  bf16x8 kf[2][2][2], vf[2][4];
#define ATTN_LOAD(Z, LK0, KF, VF) do { \
    const int g0_ = (LK0) >> 4; \
    _Pragma("unroll") for (int u = 0; u < 2; ++u) { \
      const int sl_ = 8 * (i16 >> 2) + 4 * u + (i16 & 3); \
      int gk_ = g0_ + (sl_ >> 4); gk_ = gk_ < 0 ? 0 : gk_; \
      const u16* kp_ = kd + ((size_t)(bhr[Z] + gk_) * 8 + g) * 128 + (sl_ & 15) * 8; \
      _Pragma("unroll") for (int kk = 0; kk < 2; ++kk) KF[u][kk] = *(const bf16x8*)(kp_ + (size_t)kk * 512); \
    } \
    { int gv_ = g0_ + (g >> 1); gv_ = gv_ < 0 ? 0 : gv_; \
      const u16* vp_ = vTd + ((size_t)(bhr[Z] + gv_) * 64 + i16) * 16 + 8 * (g & 1); \
      _Pragma("unroll") for (int c = 0; c < 4; ++c) VF[c] = *(const bf16x8*)(vp_ + c * 256); } \
  } while (0)
  for (int st = 0; st < nsteps; ++st) {
    ATTN_LOAD(0, first[0] + 32 * st, kf[0], vf[0]);
    ATTN_LOAD(1, first[1] + 32 * st, kf[1], vf[1]);
#pragma unroll
    for (int z = 0; z < 2; ++z) {
      const int lk0 = first[z] + 32 * st;
      f32x4 sa[2];
#pragma unroll
      for (int u = 0; u < 2; ++u) {
        sa[u] = MFMA16(kf[z][u][0], qf[z][0], (f32x4{0.f, 0.f, 0.f, 0.f}));
        sa[u] = MFMA16(kf[z][u][1], qf[z][1], sa[u]);
      }
      float s[8];
      float mx = -1e30f;
      const bool interior = (lk0 >= 0) && (l0[z] - lk0 >= 31) && (l0[z] + 15 - lk0 <= 128);
      const float dl0 = (float)(lq[z] - lk0 - 8 * g);
      if (interior) {
#pragma unroll
        for (int u = 0; u < 2; ++u)
#pragma unroll
          for (int j = 0; j < 4; ++j) {
            const float sv = sa[u][j] * c1 - c2d * (dl0 - (float)(4 * u + j));
            s[4 * u + j] = sv;
            mx = fmaxf(mx, sv);
          }
      } else {
#pragma unroll
        for (int u = 0; u < 2; ++u)
#pragma unroll
          for (int j = 0; j < 4; ++j) {
            const int lk = lk0 + 8 * g + 4 * u + j;
            const int dl = lq[z] - lk;
            const bool valid = (dl >= 0) && (dl <= 128) && (lk >= 0);
            const float sv = valid ? (sa[u][j] * c1 - c2d * (float)dl) : -1e30f;
            s[4 * u + j] = sv;
            mx = fmaxf(mx, sv);
          }
      }
      mx = fmaxf(mx, __shfl_xor(mx, 16, 64));
      mx = fmaxf(mx, __shfl_xor(mx, 32, 64));
      const float mn = fmaxf(m[z], mx);
      const float al = __builtin_amdgcn_exp2f(m[z] - mn);
      m[z] = mn;
      float ps = 0.f;
      float pv[8];
      if (interior) {
#pragma unroll
        for (int e = 0; e < 8; ++e) { pv[e] = __builtin_amdgcn_exp2f(s[e] - mn); ps += pv[e]; }
      } else {
#pragma unroll
        for (int e = 0; e < 8; ++e) { pv[e] = (s[e] > -1e29f) ? __builtin_amdgcn_exp2f(s[e] - mn) : 0.f; ps += pv[e]; }
      }
      l[z] = l[z] * al + ps;
#pragma unroll
      for (int c = 0; c < 4; ++c) O[z][c] = O[z][c] * al;
      union { bf16x8 v; unsigned u[4]; } pf;
      pf.u[0] = pack2(pv[0], pv[1]); pf.u[1] = pack2(pv[2], pv[3]); pf.u[2] = pack2(pv[4], pv[5]); pf.u[3] = pack2(pv[6], pv[7]);
#pragma unroll
      for (int c = 0; c < 4; ++c) O[z][c] = MFMA16(vf[z][c], pf.v, O[z][c]);
    }
  }
#undef ATTN_LOAD
#pragma unroll
  for (int z = 0; z < 2; ++z) {
    float lz = l[z];
    lz += __shfl_xor(lz, 16, 64);
    lz += __shfl_xor(lz, 32, 64);
    m_out[z] = m[z]; l_out[z] = lz;
  }
}

constexpr int AST_PITCH = 68;
DI float* ast_ptr(float* Ost, int pos, int c, int g) { return Ost + pos * AST_PITCH + 4 * ((4 * c + g) ^ ((pos >> 4) & 15)); }

DI void phase_attn(const Params& p, char* smem) {
  const u16* qb = (const u16*)(p.ws + WS_Q); const u16* kb = (const u16*)(p.ws + WS_K);
  const u16* vT1 = (const u16*)(p.ws + WS_VT); const u16* vT4 = (const u16*)(p.ws + WS_VT4); const u16* vT16 = (const u16*)(p.ws + WS_VT16);
  const u16* k4 = (const u16*)(p.ws + WS_K4); const u16* k16 = (const u16*)(p.ws + WS_K16);
  u16* mix = (u16*)(p.ws + WS_MIX);
  float* Ost = (float*)smem; float* mst = Ost + 256 * AST_PITCH; float* lst = mst + 256;
  const int lane = threadIdx.x & 63, w = __builtin_amdgcn_readfirstlane(threadIdx.x >> 6), g = lane >> 4, i16 = lane & 15;
  for (int item = blockIdx.x; item < 1024; item += gridDim.x) {
    {
      const size_t vt_ = (size_t)item * NT + threadIdx.x, vsz_ = (size_t)1024 * NT;
      cvt_rows_i8(p.ut, p.ws + WS_UB, (float*)(p.ws + WS_SU), (size_t)16384 * DM / 16, vt_, vsz_);
      cvt_linear_fp8(p.vt, p.ws + WS_VB, (size_t)16384 * DM / 16, V_SCALE, vt_, vsz_);
    }
    const int qblk = 7 - (item >> 7), bh = item & 127, b = bh >> 3, h = bh & 7;
    const int t0 = qblk * 256;
    const float c2 = exp2f(-(float)(h + 1)) * LOG2E;
    {
      f32x4 O[2][4]; float m[2], l[2];
      attn_task2<1>(qb, kb, vT1, b, h, 0, t0 + 32 * w, 0, t0 + 32 * w + 16, c2, O, m, l);
#pragma unroll
      for (int z = 0; z < 2; ++z) {
        const int pos = 16 * (2 * w + z) + i16;
#pragma unroll
        for (int c = 0; c < 4; ++c) *(f32x4*)ast_ptr(Ost, pos, c, g) = O[z][c];
        if (g == 0) { mst[pos] = m[z]; lst[pos] = l[z]; }
      }
    }
    __syncthreads();
    {
      const int i = (2 * w) >> 2, r0 = (2 * w) & 3;
      f32x4 O[2][4]; float m[2], l[2];
      attn_task2<4>(qb, k4, vT4, b, h, r0, (t0 >> 2) + 16 * i, r0 + 1, (t0 >> 2) + 16 * i, c2, O, m, l);
#pragma unroll
      for (int z = 0; z < 2; ++z) {
        const int pos = 64 * i + 4 * i16 + r0 + z;
        const float mo = mst[pos], lo = lst[pos];
        const float mn = fmaxf(mo, m[z]), ao = __builtin_amdgcn_exp2f(mo - mn), an = __builtin_amdgcn_exp2f(m[z] - mn);
#pragma unroll
        for (int c = 0; c < 4; ++c) { float* q = ast_ptr(Ost, pos, c, g); const f32x4 old = *(const f32x4*)q; *(f32x4*)q = old * ao + O[z][c] * an; }
        if (g == 0) { mst[pos] = mn; lst[pos] = lo * ao + l[z] * an; }
      }
    }
    __syncthreads();
    {
      f32x4 O[2][4]; float m[2], l[2];
      attn_task2<16>(qb, k16, vT16, b, h, 2 * w, t0 >> 4, 2 * w + 1, t0 >> 4, c2, O, m, l);
#pragma unroll
      for (int z = 0; z < 2; ++z) {
        const int pos = 16 * i16 + 2 * w + z;
        const float mo = mst[pos], lo = lst[pos];
        const float mn = fmaxf(mo, m[z]), ao = __builtin_amdgcn_exp2f(mo - mn), an = __builtin_amdgcn_exp2f(m[z] - mn);
        const float inv = 1.f / (lo * ao + l[z] * an);
        u16* orow = mix + (size_t)(b * SEQ + t0 + pos) * 1024 + 512 + h * 64 + 4 * g;
#pragma unroll
        for (int c = 0; c < 4; ++c) {
          const f32x4 old = *(const f32x4*)ast_ptr(Ost, pos, c, g);
          const f32x4 o = (old * ao + O[z][c] * an) * inv;
          uint2 v; v.x = pack2(o[0], o[1]); v.y = pack2(o[2], o[3]);
          *(uint2*)(orow + 16 * c) = v;
        }
      }
    }
    __syncthreads();
  }
}

DI void phase_conv(const Params& p, char* smem) {
  const u16* pu = (const u16*)(p.ws + WS_PU);
  u16* mix = (u16*)(p.ws + WS_MIX);
  u16* glu = (u16*)smem;
  const int tid = threadIdx.x, lane = tid & 63, w = __builtin_amdgcn_readfirstlane(tid >> 6);
  for (int item = blockIdx.x; item < 512; item += gridDim.x) {
    const int b = item >> 5, s0 = (item & 31) * 64;
    __syncthreads();
    for (int q = tid; q < 94 * 64; q += NT) {
      const int row = q >> 6, c8 = q & 63;
      const int s = s0 - 30 + row;
      uint4 r = uint4{0u, 0u, 0u, 0u};
      if (s >= 0) {
        const u16* src = pu + (size_t)(b * SEQ + s) * 1024 + c8 * 8;
        const uint4 a = *(const uint4*)src, gt = *(const uint4*)(src + 512);
        const unsigned aw[4] = {a.x, a.y, a.z, a.w}, gw[4] = {gt.x, gt.y, gt.z, gt.w};
        unsigned ow[4];
#pragma unroll
        for (int k = 0; k < 4; ++k) {
          const float a0 = bflo(aw[k]), a1 = bfhi(aw[k]), g0 = bflo(gw[k]), g1 = bfhi(gw[k]);
          ow[k] = pack2(a0 / (1.f + __expf(-g0)), a1 / (1.f + __expf(-g1)));
        }
        r = uint4{ow[0], ow[1], ow[2], ow[3]};
      }
      *(uint4*)(glu + row * 512 + c8 * 8) = r;
    }
    __syncthreads();
    float acc[8][8];
    {
      const float4 b0 = *(const float4*)(p.conv_b + lane * 8), b1 = *(const float4*)(p.conv_b + lane * 8 + 4);
#pragma unroll
      for (int i = 0; i < 8; ++i) { acc[i][0] = b0.x; acc[i][1] = b0.y; acc[i][2] = b0.z; acc[i][3] = b0.w; acc[i][4] = b1.x; acc[i][5] = b1.y; acc[i][6] = b1.z; acc[i][7] = b1.w; }
    }
#pragma unroll 4
    for (int j = 0; j < 31; ++j) {
      const float4 w0 = *(const float4*)(p.conv_w + j * 512 + lane * 8), w1 = *(const float4*)(p.conv_w + j * 512 + lane * 8 + 4);
      const float wj[8] = {w0.x, w0.y, w0.z, w0.w, w1.x, w1.y, w1.z, w1.w};
#pragma unroll
      for (int i = 0; i < 8; ++i) {
        const uint4 v = *(const uint4*)(glu + (8 * w + i + j) * 512 + lane * 8);
        acc[i][0] += wj[0] * bflo(v.x); acc[i][1] += wj[1] * bfhi(v.x);
        acc[i][2] += wj[2] * bflo(v.y); acc[i][3] += wj[3] * bfhi(v.y);
        acc[i][4] += wj[4] * bflo(v.z); acc[i][5] += wj[5] * bfhi(v.z);
        acc[i][6] += wj[6] * bflo(v.w); acc[i][7] += wj[7] * bfhi(v.w);
      }
    }
    const float4 g0 = *(const float4*)(p.cln_g + lane * 8), g1 = *(const float4*)(p.cln_g + lane * 8 + 4);
    const float4 c0 = *(const float4*)(p.cln_b + lane * 8), c1 = *(const float4*)(p.cln_b + lane * 8 + 4);
    const float gg[8] = {g0.x, g0.y, g0.z, g0.w, g1.x, g1.y, g1.z, g1.w};
    const float cb[8] = {c0.x, c0.y, c0.z, c0.w, c1.x, c1.y, c1.z, c1.w};
#pragma unroll
    for (int i = 0; i < 8; ++i) {
      float sm = 0.f;
#pragma unroll
      for (int k = 0; k < 8; ++k) sm += acc[i][k];
      const float mean = wave_sum(sm) * (1.f / 512.f);
      float sq = 0.f;
#pragma unroll
      for (int k = 0; k < 8; ++k) { const float d = acc[i][k] - mean; sq += d * d; }
      const float rstd = rsqrtf(wave_sum(sq) * (1.f / 512.f) + LN_EPS);
      float o[8];
#pragma unroll
      for (int k = 0; k < 8; ++k) { const float y = (acc[i][k] - mean) * rstd * gg[k] + cb[k]; o[k] = y / (1.f + __expf(-y)); }
      uint4 r; r.x = pack2(o[0], o[1]); r.y = pack2(o[2], o[3]); r.z = pack2(o[4], o[5]); r.w = pack2(o[6], o[7]);
      *(uint4*)(mix + (size_t)(b * SEQ + s0 + 8 * w + i) * 1024 + lane * 8) = r;
    }
  }
}

DI void outproj_epilogue(const Params& p, const char* smem, const int m0, const int n0) {
  u16* rbuf = (u16*)(p.ws + WS_PU);
  const u16* xb = (const u16*)(p.ws + WS_XB);
  const float* ct = (const float*)smem;
#pragma unroll 4
  for (int i = 0; i < 16; ++i) {
    const int c = threadIdx.x + NT * i, row = c >> 5, ch = c & 31;
    const float4 y = *(const float4*)(ct + row * CT_PITCH + 4 * ch);
    const size_t o = (size_t)(m0 + row) * 1024 + n0 + 4 * ch;
    const uint2 xq = *(const uint2*)(xb + o); const float4 xv = float4{bflo(xq.x), bfhi(xq.x), bflo(xq.y), bfhi(xq.y)}, bv = *(const float4*)(p.b_out + n0 + 4 * ch);
    uint2 r; r.x = pack2(ALPHA * xv.x + y.x + bv.x, ALPHA * xv.y + y.y + bv.y); r.y = pack2(ALPHA * xv.z + y.z + bv.z, ALPHA * xv.w + y.w + bv.w);
    *(uint2*)(rbuf + o) = r;
  }
}
DI void phase_outproj(const Params& p, char* smem) {
  const u16* mix = (const u16*)(p.ws + WS_MIX);
  const u16* wt = (const u16*)(p.ws + WS_WOUT);
  const int lane = threadIdx.x & 63, g = lane >> 4, r16 = lane & 15;
  const int NTN = DM / 256;
  for (int tile = blockIdx.x, kit = 0; tile < (T / 256) * NTN; tile += gridDim.x, ++kit) {
    int mt_, nt_; tile_coords<4>(tile, kit, T / 256, NTN, mt_, nt_);
    const int m0 = mt_ * 256, n0b = nt_ * 256;
    f32x4 acc[8][4];
    gemm_tile_big(mix, wt, DM, m0, n0b, smem, acc);
    stage_acc_big<0>(acc, smem, g, r16);
    __syncthreads();
    outproj_epilogue(p, smem, m0, n0b);
    __syncthreads();
    stage_acc_big<1>(acc, smem, g, r16);
    __syncthreads();
    outproj_epilogue(p, smem, m0, n0b + 128);
    __syncthreads();
  }
}

DI void phase_ln1(const Params& p) {
  const u16* rbuf = (const u16*)(p.ws + WS_PU);
  u16* h1b = (u16*)(p.ws + WS_XB);
  unsigned char* h1f8 = p.ws + WS_H1F8;
  const int lane = threadIdx.x & 63, w = __builtin_amdgcn_readfirstlane(threadIdx.x >> 6);
  float4 gg[4], bb[4];
#pragma unroll
  for (int k = 0; k < 4; ++k) { gg[k] = *(const float4*)(p.ln1_g + 256 * k + 4 * lane); bb[k] = *(const float4*)(p.ln1_b + 256 * k + 4 * lane); }
  for (int tb = blockIdx.x; tb < T / 8; tb += 2 * gridDim.x) {
    const int tb1 = tb + (int)gridDim.x < T / 8 ? tb + (int)gridDim.x : tb;
    const int tt[2] = {tb * 8 + w, tb1 * 8 + w};
    float4 v[2][4];
#pragma unroll
    for (int z = 0; z < 2; ++z)
#pragma unroll
      for (int k = 0; k < 4; ++k) {
        const uint2 q = *(const uint2*)(rbuf + (size_t)tt[z] * 1024 + 256 * k + 4 * lane);
        v[z][k] = float4{bflo(q.x), bfhi(q.x), bflo(q.y), bfhi(q.y)};
      }
#pragma unroll
    for (int z = 0; z < 2; ++z) {
      const int t = tt[z];
      float sm = 0.f;
#pragma unroll
      for (int k = 0; k < 4; ++k) sm += v[z][k].x + v[z][k].y + v[z][k].z + v[z][k].w;
      const float mean = wave_sum(sm) * (1.f / 1024.f);
      float sq = 0.f;
#pragma unroll
      for (int k = 0; k < 4; ++k) { float d; d = v[z][k].x - mean; sq += d * d; d = v[z][k].y - mean; sq += d * d; d = v[z][k].z - mean; sq += d * d; d = v[z][k].w - mean; sq += d * d; }
      const float rstd = rsqrtf(wave_sum(sq) * (1.f / 1024.f) + LN_EPS);
      float4 o[4];
      float am = 0.f;
#pragma unroll
      for (int k = 0; k < 4; ++k) {
        const int d0 = 256 * k + 4 * lane;
        o[k].x = (v[z][k].x - mean) * rstd * gg[k].x + bb[k].x; o[k].y = (v[z][k].y - mean) * rstd * gg[k].y + bb[k].y;
        o[k].z = (v[z][k].z - mean) * rstd * gg[k].z + bb[k].z; o[k].w = (v[z][k].w - mean) * rstd * gg[k].w + bb[k].w;
        am = fmaxf(am, fmaxf(fmaxf(fabsf(o[k].x), fabsf(o[k].y)), fmaxf(fabsf(o[k].z), fabsf(o[k].w))));
        uint2 hb; hb.x = pack2(o[k].x, o[k].y); hb.y = pack2(o[k].z, o[k].w);
        *(uint2*)(h1b + (size_t)t * 1024 + d0) = hb;
      }
#pragma unroll
      for (int of = 32; of > 0; of >>= 1) am = fmaxf(am, __shfl_xor(am, of, 64));
      am = fmaxf(am, 1e-30f);
      const float q = 127.f / am;
#pragma unroll
      for (int k = 0; k < 4; ++k) *(unsigned*)(h1f8 + (size_t)t * 1024 + 256 * k + 4 * lane) = pk4_i8(o[k].x * q, o[k].y * q, o[k].z * q, o[k].w * q);
      if (lane == 0) ((float*)(p.ws + WS_SX))[t] = am * (1.f / 127.f);
    }
  }
}

DI unsigned enc_key(float s) { const unsigned u = __float_as_uint(s); return (u & 0x80000000u) ? ~u : (u | 0x80000000u); }
DI float dec_key(unsigned k) { const unsigned u = (k & 0x80000000u) ? (k & 0x7fffffffu) : ~k; return __uint_as_float(u); }
DI void cswap(unsigned& a, unsigned& b) { const unsigned hi = a > b ? a : b, lo = a > b ? b : a; a = hi; b = lo; }

DI void sort16_desc(unsigned (&v)[16]) {
  constexpr int KS[10] = {2, 4, 4, 8, 8, 8, 16, 16, 16, 16};
  constexpr int JS[10] = {1, 2, 1, 4, 2, 1, 8, 4, 2, 1};
#pragma unroll
  for (int s = 0; s < 10; ++s) {
#pragma unroll
    for (int i = 0; i < 16; ++i) {
      const int l = i ^ JS[s];
      if (l > i) {
        if ((i & KS[s]) == 0) cswap(v[i], v[l]); else cswap(v[l], v[i]);
      }
    }
  }
}
DI void merge16_desc(unsigned (&R)[16], const unsigned (&X)[16]) {
#pragma unroll
  for (int i = 0; i < 16; ++i) R[i] = R[i] > X[15 - i] ? R[i] : X[15 - i];
  constexpr int JS[4] = {8, 4, 2, 1};
#pragma unroll
  for (int s = 0; s < 4; ++s) {
#pragma unroll
    for (int i = 0; i < 16; ++i) {
      const int l = i ^ JS[s];
      if (l > i) cswap(R[i], R[l]);
    }
  }
}

struct CandTab { int i[64]; int j[64]; int n; };
constexpr CandTab make_cands() {
  CandTab t{};
  int n = 0;
  for (int i = 0; i < 16; ++i)
    for (int j = 0; j < 16; ++j)
      if ((i + 1) * (j + 1) <= 16) { t.i[n] = i; t.j[n] = j; ++n; }
  t.n = n;
  for (int k = n; k < 64; ++k) { t.i[k] = 0; t.j[k] = 0; }
  return t;
}

DI void phase_peer_q(const Params& p, char* smem) {
  const u16* h1b = (const u16*)(p.ws + WS_XB);
  const u16* wt = (const u16*)(p.ws + WS_WQ);
  const u16* keysb = (const u16*)(p.ws + WS_KEYS);
  int* sel_i = (int*)(p.ws + WS_SELI);
  float* sel_g = (float*)(p.ws + WS_SELG);
  float* Sbuf = (float*)smem;
  unsigned* xch = (unsigned*)(smem + 128 * 257 * 4);
  const int tid = threadIdx.x, lane = tid & 63, w = __builtin_amdgcn_readfirstlane(tid >> 6), g = lane >> 4, r16 = lane & 15;
  constexpr int WM = 2;
  const int wm = w % WM, wn = w / WM;
  for (int tile = blockIdx.x, kit = 0; tile < (T / 128) * 8; tile += gridDim.x, ++kit) {
    int mt_, nt_; tile_coords<8>(tile, kit, T / 128, 8, mt_, nt_);
    const int m0 = mt_ * 128, hd = nt_, n0 = hd * 256;
    {
      f32x4 acc[4][4];
      gemm_tile<WM>(h1b, wt, DM, m0, n0, smem, acc);
#pragma unroll
      for (int mi = 0; mi < 4; ++mi)
#pragma unroll
        for (int ni = 0; ni < 4; ++ni)
#pragma unroll
          for (int j = 0; j < 4; ++j) {
            const int row = 64 * wm + 16 * mi + 4 * g + j, col = 64 * wn + 16 * ni + r16;
            *(u16*)(smem + row * 512 + (((col >> 3) ^ (row & 15)) << 4) + (col & 7) * 2) = f2bf(acc[mi][ni][j]);
          }
    }
    __syncthreads();
    f32x4 sc[2][2][4];
    {
      const int swm = w & 3, swn = w >> 2;
#pragma unroll
      for (int pp = 0; pp < 2; ++pp) {
#pragma unroll
        for (int mi = 0; mi < 2; ++mi)
#pragma unroll
          for (int ni = 0; ni < 4; ++ni) sc[pp][mi][ni] = f32x4{0.f, 0.f, 0.f, 0.f};
        bf16x8 bfr[4][4];
#pragma unroll
        for (int kk = 0; kk < 4; ++kk)
#pragma unroll
          for (int ni = 0; ni < 4; ++ni) {
            const int n = 64 * swn + 16 * ni + r16;
            bfr[kk][ni] = *(const bf16x8*)(keysb + ((size_t)(((hd * 2 + pp) * 4 + kk) * 4 + g) * 128 + n) * 8);
          }
#pragma unroll
        for (int kk = 0; kk < 4; ++kk) {
          bf16x8 af[2];
#pragma unroll
          for (int mi = 0; mi < 2; ++mi) {
            const int row = 32 * swm + 16 * mi + r16, c = 16 * pp + 4 * kk + g;
            af[mi] = *(const bf16x8*)(smem + row * 512 + ((c ^ (row & 15)) << 4));
          }
#pragma unroll
          for (int mi = 0; mi < 2; ++mi)
#pragma unroll
            for (int ni = 0; ni < 4; ++ni) sc[pp][mi][ni] = MFMA16(af[mi], bfr[kk][ni], sc[pp][mi][ni]);
        }
      }
      __syncthreads();
#pragma unroll
      for (int pp = 0; pp < 2; ++pp)
#pragma unroll
        for (int mi = 0; mi < 2; ++mi)
#pragma unroll
          for (int ni = 0; ni < 4; ++ni)
#pragma unroll
            for (int j = 0; j < 4; ++j) {
              const int row = 32 * swm + 16 * mi + 4 * g + j, n = 64 * swn + 16 * ni + r16;
              Sbuf[row * 257 + pp * 128 + n] = sc[pp][mi][ni][j];
            }
    }
    __syncthreads();
    unsigned R[16];
    const int tok = tid & 127, half = (tid >> 7) & 1;
    if (tid < 256) {
      const float* srow = Sbuf + tok * 257 + half * 128;
#pragma unroll
      for (int i = 0; i < 16; ++i) R[i] = (enc_key(srow[i]) & ~127u) | (unsigned)(127 - i);
      sort16_desc(R);
#pragma unroll 1
      for (int gi = 1; gi < 8; ++gi) {
        unsigned X[16];
#pragma unroll
        for (int i = 0; i < 16; ++i) X[i] = (enc_key(srow[gi * 16 + i]) & ~127u) | (unsigned)(127 - (gi * 16 + i));
        sort16_desc(X);
        merge16_desc(R, X);
      }
#pragma unroll
      for (int i = 0; i < 16; ++i) xch[(tok * 2 + half) * 16 + i] = R[i];
    }
    __syncthreads();
    if (tid < 128) {
      constexpr CandTab CT = make_cands();
      float s1[16], s2[16];
#pragma unroll
      for (int i = 0; i < 16; ++i) { s1[i] = dec_key(R[i] & ~127u); s2[i] = dec_key(xch[(tok * 2 + 1) * 16 + i] & ~127u); }
      unsigned B[16];
#pragma unroll
      for (int gi = 0; gi < 4; ++gi) {
        unsigned X[16];
#pragma unroll
        for (int i = 0; i < 16; ++i) {
          const int c = gi * 16 + i;
          X[i] = (c < CT.n) ? ((enc_key(s1[CT.i[c]] + s2[CT.j[c]]) & ~255u) | (unsigned)(255 - (CT.i[c] * 16 + CT.j[c]))) : 0u;
        }
        sort16_desc(X);
        if (gi == 0) {
#pragma unroll
          for (int i = 0; i < 16; ++i) B[i] = X[i];
        } else merge16_desc(B, X);
      }
      float e[16], sum = 0.f;
      const float s0 = dec_key(B[0] & ~255u);
#pragma unroll
      for (int i = 0; i < 16; ++i) { e[i] = __expf(dec_key(B[i] & ~255u) - s0); sum += e[i]; }
      const float inv = 1.f / sum;
      int ids[16];
#pragma unroll
      for (int i = 0; i < 16; ++i) {
        const int flat = 255 - (int)(B[i] & 255u);
        const int i1 = 127 - (int)(xch[(tok * 2 + 0) * 16 + (flat >> 4)] & 127u);
        const int i2 = 127 - (int)(xch[(tok * 2 + 1) * 16 + (flat & 15)] & 127u);
        ids[i] = i1 * 128 + i2;
        e[i] *= inv;
      }
      int* di = sel_i + (size_t)(m0 + tok) * 128 + hd * 16;
      float* dg = sel_g + (size_t)(m0 + tok) * 128 + hd * 16;
#pragma unroll
      for (int k = 0; k < 4; ++k) {
        *(int4*)(di + 4 * k) = int4{ids[4 * k], ids[4 * k + 1], ids[4 * k + 2], ids[4 * k + 3]};
        *(float4*)(dg + 4 * k) = float4{e[4 * k], e[4 * k + 1], e[4 * k + 2], e[4 * k + 3]};
      }
    }
    __syncthreads();
  }
}

DI unsigned xcc_id() { return (unsigned)__builtin_amdgcn_s_getreg((3 << 11) | 20) & 0xFu; }
DI unsigned ld_agent(const unsigned* q) { return __hip_atomic_load(q, __ATOMIC_RELAXED, __HIP_MEMORY_SCOPE_AGENT); }

DI void fp8x16_to_f32(const uint4& q, f32x2 (&x)[8]) {
  const unsigned w[4] = {q.x, q.y, q.z, q.w};
#pragma unroll
  for (int k = 0; k < 4; ++k) { x[2 * k] = __builtin_amdgcn_cvt_pk_f32_fp8((int)w[k], false); x[2 * k + 1] = __builtin_amdgcn_cvt_pk_f32_fp8((int)w[k], true); }
}
struct SliceOwner { unsigned mine; int nblk; };
DI SliceOwner read_census(const Params& p, const unsigned my_xcc) {
  const unsigned* census = (const unsigned*)(p.ws + WS_BAR) + 64;
  unsigned cnt[8]; unsigned fallback = 8;
#pragma unroll
  for (int x = 7; x >= 0; --x) { cnt[x] = ld_agent(census + 64 * x); if (cnt[x] > 0) fallback = x; }
  SliceOwner o; o.mine = 0u; o.nblk = 1;
#pragma unroll
  for (int x = 0; x < 8; ++x) {
    const unsigned owner = cnt[x] > 0 ? (unsigned)x : fallback;
    if (owner == my_xcc) o.mine |= 1u << x;
    if ((unsigned)x == my_xcc) o.nblk = (int)cnt[x];
  }
  return o;
}

DI void eu_load(const unsigned char* __restrict__ ub8, const int id0, const int id1, const int cs, const int lane, uint4 (&u)[16]) {
#pragma unroll
  for (int i = 0; i < 16; ++i) {
    const int id = __shfl(i < 8 ? id0 : id1, (8 * i + (lane >> 3)) & 63, 64);
    u[i] = *(const uint4*)(ub8 + (size_t)id * 1024 + 128 * cs + 16 * (lane & 7));
  }
}
DI void eu_compute(const uint4 (&u)[16], const uint4& xq, int* __restrict__ pd, const int lane) {
  int p[16];
#pragma unroll
  for (int i = 0; i < 16; ++i) {
    int acc = __builtin_amdgcn_sdot4((int)u[i].x, (int)xq.x, 0, false);
    acc = __builtin_amdgcn_sdot4((int)u[i].y, (int)xq.y, acc, false);
    acc = __builtin_amdgcn_sdot4((int)u[i].z, (int)xq.z, acc, false);
    p[i] = __builtin_amdgcn_sdot4((int)u[i].w, (int)xq.w, acc, false);
  }
  int q8[8], q4[4], q2[2];
  const bool b2 = lane & 4, b1 = lane & 2, b0 = lane & 1;
#pragma unroll
  for (int j = 0; j < 8; ++j) { const int keep = b2 ? p[8 + j] : p[j], send = b2 ? p[j] : p[8 + j]; q8[j] = keep + __shfl_xor(send, 4, 64); }
#pragma unroll
  for (int j = 0; j < 4; ++j) { const int keep = b1 ? q8[4 + j] : q8[j], send = b1 ? q8[j] : q8[4 + j]; q4[j] = keep + __shfl_xor(send, 2, 64); }
#pragma unroll
  for (int j = 0; j < 2; ++j) { const int keep = b0 ? q4[2 + j] : q4[j], send = b0 ? q4[j] : q4[2 + j]; q2[j] = keep + __shfl_xor(send, 1, 64); }
  const int slot0 = 16 * (lane & 7) + (lane >> 3);
  pd[slot0] = q2[0];
  pd[slot0 + 8] = q2[1];
}
DI void phase_eu(const Params& p, const unsigned my_xcc, const unsigned my_rank) {
  const unsigned char* h1f8 = p.ws + WS_H1F8;
  const unsigned char* ub8 = p.ws + WS_UB;
  const int* sel_i = (const int*)(p.ws + WS_SELI);
  int* pdot = (int*)(p.ws + WS_PDOT);
  const int lane = threadIdx.x & 63, w = __builtin_amdgcn_readfirstlane(threadIdx.x >> 6);
  const SliceOwner so = read_census(p, my_xcc);
#pragma unroll 1
  for (int cs = 0; cs < 8; ++cs) {
    if (!((so.mine >> cs) & 1u)) continue;
    const int nblk = so.nblk;
    int* pd = pdot + (size_t)cs * T * 128;
    if ((int)my_rank >= T / 8) continue;
    const int K = (T / 8 - (int)my_rank + nblk - 1) / nblk;
#define TOK(k) (((int)my_rank + ((k) < K ? (k) : K - 1) * nblk) * 8 + w)
#define EU_IDS(t, i0, i1, xq) do { i0 = sel_i[(size_t)(t) * 128 + lane]; i1 = sel_i[(size_t)(t) * 128 + 64 + lane]; \
                                   xq = *(const uint4*)(h1f8 + (size_t)(t) * 1024 + 128 * cs + 16 * (lane & 7)); } while (0)
    int tA = TOK(0), tB = TOK(1);
    int a0, a1, b0, b1; uint4 xa, xb;
    EU_IDS(tA, a0, a1, xa);
    EU_IDS(tB, b0, b1, xb);
    uint4 uA[16], uB[16];
    eu_load(ub8, a0, a1, cs, lane, uA);
    for (int k = 0; k < K; k += 2) {
      eu_load(ub8, b0, b1, cs, lane, uB);
      const int tA2 = TOK(k + 2); int na0, na1; uint4 nxa;
      EU_IDS(tA2, na0, na1, nxa);
      eu_compute(uA, xa, pd + (size_t)tA * 128, lane);
      eu_load(ub8, na0, na1, cs, lane, uA);
      const int tB2 = TOK(k + 3); int nb0, nb1; uint4 nxb;
      EU_IDS(tB2, nb0, nb1, nxb);
      eu_compute(uB, xb, pd + (size_t)tB * 128, lane);
      tA = tA2; a0 = na0; a1 = na1; xa = nxa; tB = tB2; b0 = nb0; b1 = nb1; xb = nxb;
    }
#undef EU_IDS
  }
}

DI void phase_ec(const Params& p) {
  const int* pdot = (const int*)(p.ws + WS_PDOT);
  const float* sel_g = (const float*)(p.ws + WS_SELG);
  const int* sel_i = (const int*)(p.ws + WS_SELI);
  const float* su = (const float*)(p.ws + WS_SU);
  const float* sx = (const float*)(p.ws + WS_SX);
  float* cbuf = (float*)(p.ws + WS_CBUF);
  const size_t gsz = (size_t)gridDim.x * NT, n = (size_t)T * 128;
  size_t i = (size_t)blockIdx.x * NT + threadIdx.x;
  for (; i + gsz < n; i += 2 * gsz) {
    int d[2] = {0, 0}; int id[2]; float g[2], s2[2];
#pragma unroll
    for (int z = 0; z < 2; ++z) {
      const size_t e = i + z * gsz;
#pragma unroll
      for (int cs = 0; cs < 8; ++cs) d[z] += pdot[(size_t)cs * T * 128 + e];
      id[z] = sel_i[e]; g[z] = sel_g[e]; s2[z] = sx[e >> 7];
    }
#pragma unroll
    for (int z = 0; z < 2; ++z) {
      const float xx = (float)d[z] * su[id[z]] * s2[z];
      const float act = 0.5f * xx * (1.f + erff(xx * 0.70710678118654752f));
      cbuf[i + z * gsz] = act * g[z] * (1.f / V_SCALE);
    }
  }
  for (; i < n; i += gsz) {
    int d = 0;
#pragma unroll
    for (int cs = 0; cs < 8; ++cs) d += pdot[(size_t)cs * T * 128 + i];
    const float xx = (float)d * su[sel_i[i]] * sx[i >> 7];
    const float act = 0.5f * xx * (1.f + erff(xx * 0.70710678118654752f));
    cbuf[i] = act * sel_g[i] * (1.f / V_SCALE);
  }
}

DI void ev_load(const unsigned char* __restrict__ vb8, const int id0, const int id1, const int cs, const int lane, uint4 (&v)[16]) {
#pragma unroll
  for (int i = 0; i < 16; ++i) {
    const int id = __shfl(i < 8 ? id0 : id1, (8 * i + (lane >> 3)) & 63, 64);
    v[i] = *(const uint4*)(vb8 + (size_t)id * 1024 + 128 * cs + 16 * (lane & 7));
  }
}
DI void ev_compute(const uint4 (&v)[16], const float c0, const float c1, u16* __restrict__ yrow, const int lane) {
  f32x2 acc[8];
#pragma unroll
  for (int k = 0; k < 8; ++k) acc[k] = f32x2{0.f, 0.f};
#pragma unroll
  for (int i = 0; i < 16; ++i) {
    const float c = __shfl(i < 8 ? c0 : c1, (8 * i + (lane >> 3)) & 63, 64);
    const f32x2 cc = f32x2{c, c};
    f32x2 vf[8];
    fp8x16_to_f32(v[i], vf);
#pragma unroll
    for (int k = 0; k < 8; ++k) acc[k] = __builtin_elementwise_fma(vf[k], cc, acc[k]);
  }
  float a[16];
#pragma unroll
  for (int k = 0; k < 8; ++k) { a[2 * k] = acc[k][0]; a[2 * k + 1] = acc[k][1]; }
  float q8[8], q4[4], q2[2];
  const bool b5 = lane & 32, b4 = lane & 16, b3 = lane & 8;
#pragma unroll
  for (int j = 0; j < 8; ++j) { const float keep = b5 ? a[8 + j] : a[j], send = b5 ? a[j] : a[8 + j]; q8[j] = keep + __shfl_xor(send, 32, 64); }
#pragma unroll
  for (int j = 0; j < 4; ++j) { const float keep = b4 ? q8[4 + j] : q8[j], send = b4 ? q8[j] : q8[4 + j]; q4[j] = keep + __shfl_xor(send, 16, 64); }
#pragma unroll
  for (int j = 0; j < 2; ++j) { const float keep = b3 ? q4[2 + j] : q4[j], send = b3 ? q4[j] : q4[2 + j]; q2[j] = keep + __shfl_xor(send, 8, 64); }
  *(unsigned*)(yrow + 16 * (lane & 7) + 2 * (lane >> 3)) = pack2(q2[0], q2[1]);
}

DI void phase_ev(const Params& p, const unsigned my_xcc, const unsigned my_rank) {
  const unsigned char* vb8 = p.ws + WS_VB;
  const int* sel_i = (const int*)(p.ws + WS_SELI);
  const float* cbuf = (const float*)(p.ws + WS_CBUF);
  u16* ybuf = (u16*)(p.ws + WS_YBUF);
  const int lane = threadIdx.x & 63, w = __builtin_amdgcn_readfirstlane(threadIdx.x >> 6);
  const SliceOwner so = read_census(p, my_xcc);
#pragma unroll 1
  for (int cs = 0; cs < 8; ++cs) {
    if (!((so.mine >> cs) & 1u)) continue;
    const int nblk = so.nblk;
    if ((int)my_rank >= T / 8) continue;
    const int K = (T / 8 - (int)my_rank + nblk - 1) / nblk;
#define EV_IDS(t, i0, i1, c0, c1) do { i0 = sel_i[(size_t)(t) * 128 + lane]; i1 = sel_i[(size_t)(t) * 128 + 64 + lane]; \
                                       c0 = cbuf[(size_t)(t) * 128 + lane]; c1 = cbuf[(size_t)(t) * 128 + 64 + lane]; } while (0)
    int tA = TOK(0), tB = TOK(1);
    int a0, a1, b0, b1; float ca0, ca1, cb0, cb1;
    EV_IDS(tA, a0, a1, ca0, ca1);
    EV_IDS(tB, b0, b1, cb0, cb1);
    uint4 vA[16], vB[16];
    ev_load(vb8, a0, a1, cs, lane, vA);
    for (int k = 0; k < K; k += 2) {
      ev_load(vb8, b0, b1, cs, lane, vB);
      const int tA2 = TOK(k + 2); int na0, na1; float nca0, nca1;
      EV_IDS(tA2, na0, na1, nca0, nca1);
      ev_compute(vA, ca0, ca1, ybuf + (size_t)tA * 1024 + 128 * cs, lane);
      ev_load(vb8, na0, na1, cs, lane, vA);
      const int tB2 = TOK(k + 3); int nb0, nb1; float ncb0, ncb1;
      EV_IDS(tB2, nb0, nb1, ncb0, ncb1);
      ev_compute(vB, cb0, cb1, ybuf + (size_t)tB * 1024 + 128 * cs, lane);
      tA = tA2; a0 = na0; a1 = na1; ca0 = nca0; ca1 = nca1; tB = tB2; b0 = nb0; b1 = nb1; cb0 = ncb0; cb1 = ncb1;
    }
#undef EV_IDS
#undef TOK
  }
}

DI void phase_ln2(const Params& p) {
  const u16* ybuf = (const u16*)(p.ws + WS_YBUF);
  const u16* h1b = (const u16*)(p.ws + WS_XB);
  const int lane = threadIdx.x & 63, w = __builtin_amdgcn_readfirstlane(threadIdx.x >> 6);
  float4 gg[4], bb[4];
#pragma unroll
  for (int k = 0; k < 4; ++k) { gg[k] = *(const float4*)(p.ln2_g + 256 * k + 4 * lane); bb[k] = *(const float4*)(p.ln2_b + 256 * k + 4 * lane); }
  constexpr int NZ = 4;
  for (int tb = blockIdx.x; tb < T / 8; tb += NZ * gridDim.x) {
    int tt[NZ];
#pragma unroll
    for (int z = 0; z < NZ; ++z) { const int tbz = tb + z * (int)gridDim.x; tt[z] = (tbz < T / 8 ? tbz : tb) * 8 + w; }
    float4 v[NZ][4];
#pragma unroll
    for (int z = 0; z < NZ; ++z)
#pragma unroll
      for (int k = 0; k < 4; ++k) {
        const uint2 hq = *(const uint2*)(h1b + (size_t)tt[z] * 1024 + 256 * k + 4 * lane);
        const uint2 yq = *(const uint2*)(ybuf + (size_t)tt[z] * 1024 + 256 * k + 4 * lane);
        const float4 y = float4{bflo(yq.x), bfhi(yq.x), bflo(yq.y), bfhi(yq.y)};
        v[z][k] = float4{ALPHA * bflo(hq.x) + y.x, ALPHA * bfhi(hq.x) + y.y, ALPHA * bflo(hq.y) + y.z, ALPHA * bfhi(hq.y) + y.w};
      }
#pragma unroll
    for (int z = 0; z < NZ; ++z) {
      float sm = 0.f;
#pragma unroll
      for (int k = 0; k < 4; ++k) sm += v[z][k].x + v[z][k].y + v[z][k].z + v[z][k].w;
      const float mean = wave_sum(sm) * (1.f / 1024.f);
      float sq = 0.f;
#pragma unroll
      for (int k = 0; k < 4; ++k) { float d; d = v[z][k].x - mean; sq += d * d; d = v[z][k].y - mean; sq += d * d; d = v[z][k].z - mean; sq += d * d; d = v[z][k].w - mean; sq += d * d; }
      const float rstd = rsqrtf(wave_sum(sq) * (1.f / 1024.f) + LN_EPS);
#pragma unroll
      for (int k = 0; k < 4; ++k) {
        float4 o;
        o.x = (v[z][k].x - mean) * rstd * gg[k].x + bb[k].x; o.y = (v[z][k].y - mean) * rstd * gg[k].y + bb[k].y;
        o.z = (v[z][k].z - mean) * rstd * gg[k].z + bb[k].z; o.w = (v[z][k].w - mean) * rstd * gg[k].w + bb[k].w;
        *(float4*)(p.out + (size_t)tt[z] * 1024 + 256 * k + 4 * lane) = o;
      }
    }
  }
}

DI void grid_barrier(unsigned* ctr, unsigned target) {
  asm volatile("s_waitcnt vmcnt(0)" ::: "memory");
  __syncthreads();
  if (threadIdx.x == 0) {
    __builtin_amdgcn_fence(__ATOMIC_RELEASE, "agent");
    asm volatile("s_waitcnt vmcnt(0)" ::: "memory");
    (void)__hip_atomic_fetch_add(ctr, 1u, __ATOMIC_RELAXED, __HIP_MEMORY_SCOPE_AGENT);
    unsigned spins = 0;
    while (__hip_atomic_load(ctr, __ATOMIC_RELAXED, __HIP_MEMORY_SCOPE_AGENT) < target) {
      __builtin_amdgcn_s_sleep(1);
      if (++spins > (1u << 24)) break;
    }
    __builtin_amdgcn_fence(__ATOMIC_ACQUIRE, "agent");
    asm volatile("s_waitcnt vmcnt(0)" ::: "memory");
  }
  __syncthreads();
}

DI void grid_barrier_xcd(unsigned* bar, const unsigned gen, const unsigned my_xcc, const unsigned n_local, const unsigned n_xcds) {
  asm volatile("s_waitcnt vmcnt(0)" ::: "memory");
  __syncthreads();
  if (threadIdx.x == 0) {
    unsigned* xcnt = bar + 768 + 32 * my_xcc;
    unsigned* top = bar + 640;
    unsigned* rel = bar + 704;
    const unsigned old = __hip_atomic_fetch_add(xcnt, 1u, __ATOMIC_RELAXED, __HIP_MEMORY_SCOPE_AGENT);
    unsigned* xrel = bar + 96 + 64 * my_xcc;
    unsigned spins = 0;
    if (old + 1u == gen * n_local) {
      __builtin_amdgcn_fence(__ATOMIC_RELEASE, "agent");
      asm volatile("s_waitcnt vmcnt(0)" ::: "memory");
      const unsigned t = __hip_atomic_fetch_add(top, 1u, __ATOMIC_RELAXED, __HIP_MEMORY_SCOPE_AGENT);
      if (t + 1u == gen * n_xcds) __hip_atomic_store(rel, gen, __ATOMIC_RELAXED, __HIP_MEMORY_SCOPE_AGENT);
      while (__hip_atomic_load(rel, __ATOMIC_RELAXED, __HIP_MEMORY_SCOPE_AGENT) < gen) {
        __builtin_amdgcn_s_sleep(1);
        if (++spins > (1u << 24)) break;
      }
      __hip_atomic_store(xrel, gen, __ATOMIC_RELAXED, __HIP_MEMORY_SCOPE_AGENT);
    } else {
      while (__hip_atomic_load(xrel, __ATOMIC_RELAXED, __HIP_MEMORY_SCOPE_AGENT) < gen) {
        __builtin_amdgcn_s_sleep(1);
        if (++spins > (1u << 24)) break;
      }
    }
    __builtin_amdgcn_fence(__ATOMIC_ACQUIRE, "agent");
    asm volatile("s_waitcnt vmcnt(0)" ::: "memory");
  }
  __syncthreads();
}

__global__ void __launch_bounds__(NT) hymba_fwd(Params p) {
  extern __shared__ __attribute__((aligned(16))) char smem[];
  const int lo = p.ph_lo, hi = p.ph_hi;
  const unsigned my_xcc = xcc_id() & 7u;
  unsigned my_rank = 0;
  if (threadIdx.x == 0) {
    my_rank = __hip_atomic_fetch_add((unsigned*)(p.ws + WS_BAR) + 64 + 64 * my_xcc, 1u, __ATOMIC_RELAXED, __HIP_MEMORY_SCOPE_AGENT);
    (void)__hip_atomic_fetch_add((unsigned*)(p.ws + WS_BAR) + 576, 1u, __ATOMIC_RELAXED, __HIP_MEMORY_SCOPE_AGENT);
  }
  if (threadIdx.x == 0) *(unsigned*)smem = my_rank;
  __syncthreads();
  my_rank = *(const unsigned*)smem;
  __syncthreads();
#define IN(k) (lo <= (k) && (k) < hi)
  unsigned bar_target = 0;
  unsigned xgen = 0, n_local = 0, n_xcds = 0;
#define SEAM(k) do { if (IN(k) && IN((k) + 1)) { \
    if (n_local == 0) { \
      if (threadIdx.x == 0) { unsigned sp_ = 0; while (ld_agent((const unsigned*)(p.ws + WS_BAR) + 576) < gridDim.x) { __builtin_amdgcn_s_sleep(1); if (++sp_ > (1u << 24)) break; } } \
      __syncthreads(); \
      _Pragma("unroll") for (int x_ = 0; x_ < 8; ++x_) { const unsigned c_ = ld_agent((const unsigned*)(p.ws + WS_BAR) + 64 + 64 * x_); n_xcds += c_ > 0; if ((unsigned)x_ == my_xcc) n_local = c_; } \
    } \
    ++xgen; grid_barrier_xcd((unsigned*)(p.ws + WS_BAR), xgen, my_xcc, n_local, n_xcds); } } while (0)
  if (IN(0)) {
    const size_t gtid = (size_t)blockIdx.x * NT + threadIdx.x, gsz = (size_t)gridDim.x * NT;
    cvt_linear(p.x, (u16*)(p.ws + WS_XB), (size_t)T * DM / 8, gtid, gsz);
    {
      u16* kd = (u16*)(p.ws + WS_KEYS);
      for (size_t i = gtid; i < (size_t)8 * 2 * 128 * 16; i += gsz) {
        const int c8 = (int)(i & 15), n = (int)((i >> 4) & 127), hp = (int)(i >> 11);
        const float4 a = *(const float4*)(p.keys + i * 8), b = *(const float4*)(p.keys + i * 8 + 4);
        *(uint4*)(kd + ((size_t)((hp * 4 + (c8 >> 2)) * 4 + (c8 & 3)) * 128 + n) * 8) = cvt8(a, b);
      }
    }
    cvt_transpose(p.w_in, (u16*)(p.ws + WS_WIN), DM, NPROJ, gtid, gsz);
  }
  SEAM(0);
  if (IN(1)) phase_inproj(p, smem);
  SEAM(1);
  if (IN(2)) { phase_attn(p, smem); phase_conv(p, smem); }
  SEAM(2);
  if (IN(3)) phase_outproj(p, smem);
  SEAM(3);
  if (IN(4)) phase_ln1(p);
  SEAM(4);
  if (IN(5)) phase_peer_q(p, smem);
  SEAM(5);
  if (IN(6)) phase_eu(p, my_xcc, my_rank);
  SEAM(6);
  if (IN(7)) phase_ec(p);
  SEAM(7);
  if (IN(8)) phase_ev(p, my_xcc, my_rank);
  SEAM(8);
  if (IN(9)) phase_ln2(p);
#undef IN
#undef SEAM
}

extern "C" void kernel_launch(void* const* d_in, const int* in_sizes, int n_in, void* d_out, int out_size, void* d_ws, size_t ws_size, hipStream_t stream) {
  static int grid = 0;
  if (grid == 0) {
    int dev = 0, cus = 0, per_cu = 0;
    hipGetDevice(&dev);
    hipDeviceGetAttribute(&cus, hipDeviceAttributeMultiprocessorCount, dev);
    hipFuncSetAttribute((const void*)hymba_fwd, hipFuncAttributeMaxDynamicSharedMemorySize, LDS_BYTES);
    if (hipOccupancyMaxActiveBlocksPerMultiprocessor(&per_cu, (const void*)hymba_fwd, NT, LDS_BYTES) != hipSuccess || per_cu < 1) {
      fprintf(stderr, "kernel_launch: occupancy query gave %d blocks per CU\n", per_cu); per_cu = 1;
    }
    (void)hipGetLastError();
    if (per_cu > 1) per_cu = 1;
    grid = cus * per_cu;
    if (ws_size < WS_END) fprintf(stderr, "kernel_launch: workspace too small: %zu < %zu\n", ws_size, (size_t)WS_END);
  }
  Params p{};
  p.x = (const float*)d_in[0]; p.w_in = (const float*)d_in[1]; p.b_in = (const float*)d_in[2]; p.conv_w = (const float*)d_in[3];
  p.conv_b = (const float*)d_in[4]; p.cln_g = (const float*)d_in[5]; p.cln_b = (const float*)d_in[6]; p.w_out = (const float*)d_in[7];
  p.b_out = (const float*)d_in[8]; p.ln1_g = (const float*)d_in[9]; p.ln1_b = (const float*)d_in[10]; p.wq = (const float*)d_in[11];
  p.keys = (const float*)d_in[12]; p.ut = (const float*)d_in[13]; p.vt = (const float*)d_in[14]; p.ln2_g = (const float*)d_in[15];
  p.ln2_b = (const float*)d_in[16];
  p.out = (float*)d_out; p.ws = (unsigned char*)d_ws;
  p.ph_lo = 0; p.ph_hi = 10;
  (void)hipMemsetAsync((unsigned char*)d_ws + WS_BAR, 0, 4096, stream);
  hipLaunchKernelGGL(hymba_fwd, dim3(grid), dim3(NT), LDS_BYTES, stream, p);
}
```
